# Optimizing an MI355X kernel written in HIP

```python
import math
import jax, jax.numpy as jnp
from jax import lax
import numpy as np

D_MODEL = 1024
BATCH = 4
SEQ = 4096
DEPTH = 1
DEC_BATCH = 128
DEC_SEQ = 4
PAST_LEN = 2048
PAGE_SIZE = 128

MIX_WIDTH = D_MODEL
ATTN_WIDTH = MIX_WIDTH // 2
SSM_WIDTH = MIX_WIDTH - ATTN_WIDTH
DIFF_HEAD_DIM = 64
N_DIFF_HEADS = ATTN_WIDTH // (2 * DIFF_HEAD_DIM)
SSM_GROUP = 16
N_SSM_GROUPS = SSM_WIDTH // SSM_GROUP
SSM_STATE = 64
N_MEM = 256
N_MEM_HEADS = 4
MEM_HEAD_DIM = D_MODEL // N_MEM_HEADS
D_FF = -(-8 * D_MODEL // (3 * 256)) * 256
IN_COLS = 3 * ATTN_WIDTH + SSM_WIDTH
Q_BLOCK = 128
RMS_EPS = 1e-6
DT_MIN = 1e-3
DT_MAX = 1e-1

kernel_name = "hybrid_diffattn_s5_memory_decoder_step"


def rms_norm(x, g):
    xf = x.astype(jnp.float32)
    xf = xf * lax.rsqrt(jnp.mean(jnp.square(xf), axis=-1, keepdims=True) + RMS_EPS)
    return (xf * g.astype(jnp.float32)).astype(x.dtype)


def alibi_slopes():
    return 2.0 ** (-8.0 * jnp.arange(1, N_DIFF_HEADS + 1, dtype=jnp.float32) / N_DIFF_HEADS)


def diff_lambda(lq1, lk1, lq2, lk2, layer):
    lam_init = 0.8 - 0.6 * math.exp(-0.3 * layer)
    dot_exp = lambda a, b: jnp.exp(jnp.sum(a.astype(jnp.float32) * b.astype(jnp.float32)))
    return dot_exp(lq1, lk1) - dot_exp(lq2, lk2) + lam_init, lam_init


def project_mixer(hn, w_in):
    b, t, _ = hn.shape
    proj = hn @ w_in
    q, k, v, u = jnp.split(proj, [ATTN_WIDTH, 2 * ATTN_WIDTH, 3 * ATTN_WIDTH], axis=-1)
    q = q.reshape(b, t, N_DIFF_HEADS, 2, DIFF_HEAD_DIM)
    k = k.reshape(b, t, N_DIFF_HEADS, 2 * DIFF_HEAD_DIM)
    v = v.reshape(b, t, N_DIFF_HEADS, 2 * DIFF_HEAD_DIM)
    return q, k, v, u


def diff_attn_core(q, k, v, q_pos, k_pos, lam):
    s = jnp.einsum("bqhcd,bkhcd->bhcqk", q, k, preferred_element_type=jnp.float32)
    s = s * (DIFF_HEAD_DIM ** -0.5)
    dist = (q_pos[:, None] - k_pos[None, :]).astype(jnp.float32)
    bias = -alibi_slopes()[:, None, None] * dist
    s = jnp.where(dist >= 0, s + bias[:, None], -jnp.inf)
    p = jax.nn.softmax(s, axis=-1)
    p = p[:, :, 0] - lam * p[:, :, 1]
    return jnp.einsum("bhqk,bkhe->bqhe", p.astype(v.dtype), v)


def prompt_diff_attention(q, k, v, lam):
    b, t = q.shape[:2]
    nb = t // Q_BLOCK
    kk = k.reshape(b, t, N_DIFF_HEADS, 2, DIFF_HEAD_DIM)
    pos = jnp.arange(t, dtype=jnp.int32)
    qb = q.reshape(b, nb, Q_BLOCK, N_DIFF_HEADS, 2, DIFF_HEAD_DIM).swapaxes(0, 1)
    pb = pos.reshape(nb, Q_BLOCK)
    ob = lax.map(lambda a: diff_attn_core(a[0], kk, v, a[1], pos, lam), (qb, pb))
    return ob.swapaxes(0, 1).reshape(b, t, N_DIFF_HEADS, 2 * DIFF_HEAD_DIM)


def sample_diff_attention(q, k_new, v_new, ck, cv, page_table, lam):
    db, t = q.shape[:2]
    past = page_table.shape[1] * PAGE_SIZE
    k_past = ck[page_table].reshape(db, past, N_DIFF_HEADS, 2 * DIFF_HEAD_DIM)
    v_past = cv[page_table].reshape(db, past, N_DIFF_HEADS, 2 * DIFF_HEAD_DIM)
    k_all = jnp.concatenate([k_past, k_new.astype(k_past.dtype)], axis=1)
    k_all = k_all.reshape(db, past + t, N_DIFF_HEADS, 2, DIFF_HEAD_DIM)
    v_all = jnp.concatenate([v_past, v_new.astype(v_past.dtype)], axis=1)
    q_pos = past + jnp.arange(t, dtype=jnp.int32)
    k_pos = jnp.arange(past + t, dtype=jnp.int32)
    return diff_attn_core(q, k_all, v_all, q_pos, k_pos, lam)


def finish_diff_heads(o, g_subln, lam_init):
    o = rms_norm(o, g_subln) * (1.0 - lam_init)
    return o.reshape(o.shape[0], o.shape[1], ATTN_WIDTH)


def s5_mix(u, h0_re, h0_im, lam_re, lam_im, log_dt, b_re, b_im, c_re, c_im, d_skip):
    b, t, _ = u.shape
    f32 = jnp.float32
    uf = u.astype(f32).reshape(b, t, N_SSM_GROUPS, SSM_GROUP)
    lam = lax.complex(lam_re.astype(f32), lam_im.astype(f32))
    dt = jnp.exp(log_dt.astype(f32))[:, None]
    lam_bar = jnp.exp(lam * dt)
    b_bar = ((lam_bar - 1.0) / lam)[..., None] * lax.complex(b_re.astype(f32), b_im.astype(f32))
    bu = jnp.einsum("btgh,gph->btgp", uf.astype(jnp.complex64), b_bar)
    h0 = lax.complex(h0_re.astype(f32), h0_im.astype(f32))
    bu = bu.at[:, 0].add(lam_bar * h0)
    a = jnp.broadcast_to(lam_bar, bu.shape)

    def combine(e1, e2):
        a1, b1 = e1
        a2, b2 = e2
        return a1 * a2, a2 * b1 + b2

    _, h = lax.associative_scan(combine, (a, bu), axis=1)
    c = lax.complex(c_re.astype(f32), c_im.astype(f32))
    y = jnp.real(jnp.einsum("btgp,ghp->btgh", h, c)) + d_skip.astype(f32) * uf
    h_last = h[:, -1]
    return y.reshape(b, t, SSM_WIDTH).astype(u.dtype), jnp.real(h_last), jnp.imag(h_last)


def merge_groups(attn_o, ssm_y, w_glu, g_ssm_out, w_out):
    y = jax.nn.gelu(ssm_y)
    y = y * jax.nn.sigmoid(y @ w_glu)
    y = rms_norm(y, g_ssm_out)
    return jnp.concatenate([attn_o, y.astype(attn_o.dtype)], axis=-1) @ w_out


def mem_kv(mem, g_mem_kv, w_mk, w_mv):
    b = mem.shape[0]
    mn = rms_norm(mem, g_mem_kv)
    k = (mn @ w_mk).reshape(b, N_MEM, N_MEM_HEADS, MEM_HEAD_DIM)
    v = (mn @ w_mv).reshape(b, N_MEM, N_MEM_HEADS, MEM_HEAD_DIM)
    return k, v


def mem_attend(hn, mk, mv, w_mq, w_mo):
    b, t, _ = hn.shape
    q = (hn @ w_mq).reshape(b, t, N_MEM_HEADS, MEM_HEAD_DIM)
    s = jnp.einsum("bqhd,bkhd->bhqk", q, mk.astype(q.dtype), preferred_element_type=jnp.float32)
    p = jax.nn.softmax(s * (MEM_HEAD_DIM ** -0.5), axis=-1)
    o = jnp.einsum("bhqk,bkhd->bqhd", p.astype(q.dtype), mv.astype(q.dtype)).reshape(b, t, D_MODEL)
    return o @ w_mo


def swiglu(hn, w_gate, w_up, w_down):
    return (jax.nn.silu(hn @ w_gate) * (hn @ w_up)) @ w_down


def setup_inputs(seed: int = 0) -> dict:
    key = jax.random.key(seed)
    keys = iter(jax.random.split(key, 64))
    f32 = jnp.float32
    n_pages = PAST_LEN // PAGE_SIZE
    n_phys = (DEC_BATCH * n_pages * 5) // 4

    def normal(shape, scale):
        return jax.random.normal(next(keys), shape, f32) * scale

    def gain(shape):
        return 1.0 + normal(shape, 0.02)

    d = {}
    d["x_prompt"] = normal((BATCH, SEQ, D_MODEL), 1.0)
    d["x_sample"] = normal((DEC_BATCH, DEC_SEQ, D_MODEL), 1.0)
    d["mem_prompt"] = normal((BATCH, N_MEM, D_MODEL), 1.0)
    d["cache_k"] = normal((DEPTH, n_phys, PAGE_SIZE, N_DIFF_HEADS, 2 * DIFF_HEAD_DIM), 1.0)
    d["cache_v"] = normal((DEPTH, n_phys, PAGE_SIZE, N_DIFF_HEADS, 2 * DIFF_HEAD_DIM), 1.0)
    d["page_table"] = jax.random.permutation(next(keys), n_phys)[: DEC_BATCH * n_pages].reshape(DEC_BATCH, n_pages).astype(jnp.int32)
    d["state_ssm_re"] = normal((DEPTH, DEC_BATCH, N_SSM_GROUPS, SSM_STATE), 0.1)
    d["state_ssm_im"] = normal((DEPTH, DEC_BATCH, N_SSM_GROUPS, SSM_STATE), 0.1)
    d["cache_mem_k"] = normal((DEPTH, DEC_BATCH, N_MEM, N_MEM_HEADS, MEM_HEAD_DIM), 1.0)
    d["cache_mem_v"] = normal((DEPTH, DEC_BATCH, N_MEM, N_MEM_HEADS, MEM_HEAD_DIM), 1.0)
    d["g_mix_pre"] = gain((DEPTH, D_MODEL))
    d["g_mix_post"] = gain((DEPTH, D_MODEL))
    d["w_in"] = normal((DEPTH, D_MODEL, IN_COLS), D_MODEL ** -0.5)
    d["lam_q1"] = normal((DEPTH, DIFF_HEAD_DIM), 0.1)
    d["lam_k1"] = normal((DEPTH, DIFF_HEAD_DIM), 0.1)
    d["lam_q2"] = normal((DEPTH, DIFF_HEAD_DIM), 0.1)
    d["lam_k2"] = normal((DEPTH, DIFF_HEAD_DIM), 0.1)
    d["g_subln"] = gain((DEPTH, 2 * DIFF_HEAD_DIM))
    n_idx = jnp.arange(SSM_STATE, dtype=f32)
    d["ssm_lam_re"] = -0.5 + normal((DEPTH, N_SSM_GROUPS, SSM_STATE), 0.01)
    d["ssm_lam_im"] = jnp.pi * n_idx + normal((DEPTH, N_SSM_GROUPS, SSM_STATE), 0.01)
    d["ssm_log_dt"] = jax.random.uniform(next(keys), (DEPTH, N_SSM_GROUPS), f32, minval=math.log(DT_MIN), maxval=math.log(DT_MAX))
    d["ssm_b_re"] = normal((DEPTH, N_SSM_GROUPS, SSM_STATE, SSM_GROUP), (0.5 / SSM_GROUP) ** 0.5)
    d["ssm_b_im"] = normal((DEPTH, N_SSM_GROUPS, SSM_STATE, SSM_GROUP), (0.5 / SSM_GROUP) ** 0.5)
    d["ssm_c_re"] = normal((DEPTH, N_SSM_GROUPS, SSM_GROUP, SSM_STATE), (0.5 / SSM_STATE) ** 0.5)
    d["ssm_c_im"] = normal((DEPTH, N_SSM_GROUPS, SSM_GROUP, SSM_STATE), (0.5 / SSM_STATE) ** 0.5)
    d["ssm_d"] = normal((DEPTH, N_SSM_GROUPS, SSM_GROUP), 1.0)
    d["w_glu"] = normal((DEPTH, SSM_WIDTH, SSM_WIDTH), SSM_WIDTH ** -0.5)
    d["g_ssm_out"] = gain((DEPTH, SSM_WIDTH))
    d["w_out"] = normal((DEPTH, MIX_WIDTH, D_MODEL), MIX_WIDTH ** -0.5)
    d["g_mem_pre"] = gain((DEPTH, D_MODEL))
    d["g_mem_post"] = gain((DEPTH, D_MODEL))
    d["g_mem_kv"] = gain((DEPTH, D_MODEL))
    d["w_mq"] = normal((DEPTH, D_MODEL, D_MODEL), D_MODEL ** -0.5)
    d["w_mk"] = normal((DEPTH, D_MODEL, D_MODEL), D_MODEL ** -0.5)
    d["w_mv"] = normal((DEPTH, D_MODEL, D_MODEL), D_MODEL ** -0.5)
    d["w_mo"] = normal((DEPTH, D_MODEL, D_MODEL), D_MODEL ** -0.5)
    d["g_ffn_pre"] = gain((DEPTH, D_MODEL))
    d["g_ffn_post"] = gain((DEPTH, D_MODEL))
    d["w_gate"] = normal((DEPTH, D_MODEL, D_FF), D_MODEL ** -0.5)
    d["w_up"] = normal((DEPTH, D_MODEL, D_FF), D_MODEL ** -0.5)
    d["w_down"] = normal((DEPTH, D_FF, D_MODEL), D_FF ** -0.5)
    return d


def reference(x_prompt, x_sample, mem_prompt, cache_k, cache_v, page_table, state_ssm_re, state_ssm_im,
              cache_mem_k, cache_mem_v, g_mix_pre, g_mix_post, w_in, lam_q1, lam_k1, lam_q2, lam_k2, g_subln,
              ssm_lam_re, ssm_lam_im, ssm_log_dt, ssm_b_re, ssm_b_im, ssm_c_re, ssm_c_im, ssm_d, w_glu, g_ssm_out,
              w_out, g_mem_pre, g_mem_post, g_mem_kv, w_mq, w_mk, w_mv, w_mo, g_ffn_pre, g_ffn_post,
              w_gate, w_up, w_down):
    y_p, y_s = x_prompt, x_sample
    kp_l, vp_l, ks_l, vs_l = [], [], [], []
    rp_l, ip_l, rs_l, is_l = [], [], [], []
    mkp_l, mvp_l = [], []
    for l in range(DEPTH):
        lam, lam_init = diff_lambda(lam_q1[l], lam_k1[l], lam_q2[l], lam_k2[l], l)
        ssm_p = (ssm_lam_re[l], ssm_lam_im[l], ssm_log_dt[l], ssm_b_re[l], ssm_b_im[l],
                 ssm_c_re[l], ssm_c_im[l], ssm_d[l])
        hp = rms_norm(y_p, g_mix_pre[l])
        hs = rms_norm(y_s, g_mix_pre[l])
        qp, kp, vp, up = project_mixer(hp, w_in[l])
        qs, ks, vs, us = project_mixer(hs, w_in[l])
        att_p = finish_diff_heads(prompt_diff_attention(qp, kp, vp, lam), g_subln[l], lam_init)
        att_s = finish_diff_heads(sample_diff_attention(qs, ks, vs, cache_k[l], cache_v[l], page_table, lam),
                                  g_subln[l], lam_init)
        zeros = jnp.zeros((x_prompt.shape[0], N_SSM_GROUPS, SSM_STATE), jnp.float32)
        ssm_yp, rp, ip = s5_mix(up, zeros, zeros, *ssm_p)
        ssm_ys, rs, is_ = s5_mix(us, state_ssm_re[l], state_ssm_im[l], *ssm_p)
        y_p = y_p + rms_norm(merge_groups(att_p, ssm_yp, w_glu[l], g_ssm_out[l], w_out[l]), g_mix_post[l])
        y_s = y_s + rms_norm(merge_groups(att_s, ssm_ys, w_glu[l], g_ssm_out[l], w_out[l]), g_mix_post[l])
        mkp, mvp = mem_kv(mem_prompt, g_mem_kv[l], w_mk[l], w_mv[l])
        hp = rms_norm(y_p, g_mem_pre[l])
        hs = rms_norm(y_s, g_mem_pre[l])
        y_p = y_p + rms_norm(mem_attend(hp, mkp, mvp, w_mq[l], w_mo[l]), g_mem_post[l])
        y_s = y_s + rms_norm(mem_attend(hs, cache_mem_k[l], cache_mem_v[l], w_mq[l], w_mo[l]), g_mem_post[l])
        hp = rms_norm(y_p, g_ffn_pre[l])
        hs = rms_norm(y_s, g_ffn_pre[l])
        y_p = y_p + rms_norm(swiglu(hp, w_gate[l], w_up[l], w_down[l]), g_ffn_post[l])
        y_s = y_s + rms_norm(swiglu(hs, w_gate[l], w_up[l], w_down[l]), g_ffn_post[l])
        kp_l.append(kp); vp_l.append(vp); ks_l.append(ks); vs_l.append(vs)
        rp_l.append(rp); ip_l.append(ip); rs_l.append(rs); is_l.append(is_)
        mkp_l.append(mkp); mvp_l.append(mvp)
    new_k_prompt = jnp.stack(kp_l, 0)
    new_v_prompt = jnp.stack(vp_l, 0)
    new_k_sample = jnp.stack(ks_l, 0)
    new_v_sample = jnp.stack(vs_l, 0)
    ssm_re_prompt = jnp.stack(rp_l, 0)
    ssm_im_prompt = jnp.stack(ip_l, 0)
    ssm_re_sample = jnp.stack(rs_l, 0)
    ssm_im_sample = jnp.stack(is_l, 0)
    mem_k_prompt = jnp.stack(mkp_l, 0)
    mem_v_prompt = jnp.stack(mvp_l, 0)
    return (y_p, y_s, new_k_prompt, new_v_prompt, new_k_sample, new_v_sample,
            ssm_re_prompt, ssm_im_prompt, ssm_re_sample, ssm_im_sample, mem_k_prompt, mem_v_prompt)
```

```cpp
#include <hip/hip_runtime.h>
#include <cstdio>
#include <cstdint>
namespace pg8 {
#define PG8_LAS __attribute__((address_space(3)))
typedef unsigned short bf16_t;
typedef short bf16x8 __attribute__((ext_vector_type(8)));
typedef float f32x4 __attribute__((ext_vector_type(4)));
typedef unsigned u32x4 __attribute__((ext_vector_type(4)));
constexpr int BM = 256, BK = 64, HALF = 128, HTB = HALF * BK * 2  , STAGE_BYTES = 8 * HTB, NXCD = 8, WGM = 8;

__host__ __device__ __forceinline__ int lds_byte(int r, int c) { const int st = (r >> 4) * 2 + (c >> 5), rr = r & 15, cc = c & 31, ob = rr * 64 + cc * 2; return st * 1024 + (ob ^ (((ob >> 9) & 1) << 5)); }
__host__ __device__ __forceinline__ void stage_rc(int b, int& R, int& C) { const int st = b / 1024, sb = b % 1024, swz = sb ^ (((sb >> 9) & 1) << 5); R = (st >> 1) * 16 + swz / 64; C = (st & 1) * 32 + (swz % 64) / 2; }
__host__ __device__ __forceinline__ int perm32(int rho) { const int n = rho >> 4, i = rho & 15; return 8 * (i >> 2) + 4 * n + (i & 3); }

struct Unit { int pm, pn; };
struct Gemm { const bf16_t* A; const bf16_t* Bt; int M, N, K; };
typedef float f32x2 __attribute__((ext_vector_type(2)));
template <class Epi, class Sched, bool ALIGN_EPI = false, bool SP2 = false>
__device__ __forceinline__ void gemm_phase(PG8_LAS unsigned char* lds, const Gemm g, const Sched& S, const Epi& E) {
    int tid_ = threadIdx.x; asm volatile("" : "+v"(tid_));
    const int tid = tid_, wid = __builtin_amdgcn_readfirstlane(tid >> 6), lane = tid & 63, wr = wid >> 2, wc = wid & 3, fr = lane & 15, fq = lane >> 4;
    const int K = g.K, nt = K / BK;
    unsigned voffA[2], voffB[2];
#pragma unroll
    for (int i = 0; i < 2; ++i) { int R, C; stage_rc(tid * 16 + i * 8192, R, C); const int Rb = Epi::PERM ? ((R & ~31) + perm32(R & 31)) : R;
        voffA[i] = (unsigned)(R * K + C) * 2u; voffB[i] = (unsigned)(Rb * K + C) * 2u; }
    const size_t kstep = (size_t)(BK * 2);
    const size_t hstep = (size_t)HALF * K * 2;
    const size_t tstep = 2 * hstep;
    const unsigned ldsw = (unsigned)wid * 1024u;
    const int aoff = lds_byte(wr * 64 + fr, fq * 8), boff = lds_byte(wc * 32 + fr, fq * 8);
#define PG8_SA(b, h) (((b) * 2 + (h)) * HTB)
#define PG8_SB(b, h) ((4 + (b) * 2 + (h)) * HTB)
#define PG8_STAGE(bufoff, gbase, voff) do { _Pragma("unroll") for (int _i = 0; _i < 2; ++_i) \
        __builtin_amdgcn_global_load_lds((const unsigned*)((const char*)(gbase) + (voff)[_i]), (PG8_LAS unsigned*)(lds + (bufoff) + ldsw + _i * 8192), 16, 0, 0); } while (0)
#define PG8_LDA(dst, b, h) do { _Pragma("unroll") for (int m = 0; m < 4; ++m) _Pragma("unroll") for (int k = 0; k < 2; ++k) dst[m][k] = *(const PG8_LAS bf16x8*)(lds + PG8_SA(b, h) + aoff + m * 2048 + k * 1024); } while (0)
#define PG8_LDB(dst, b, h) do { _Pragma("unroll") for (int n = 0; n < 2; ++n) _Pragma("unroll") for (int k = 0; k < 2; ++k) dst[n][k] = *(const PG8_LAS bf16x8*)(lds + PG8_SB(b, h) + boff + n * 2048 + k * 1024); } while (0)
#define PG8_MMA(ai, bj, At, Bt) do { __builtin_amdgcn_s_setprio(1); _Pragma("unroll") for (int m = 0; m < 4; ++m) _Pragma("unroll") for (int n = 0; n < 2; ++n) _Pragma("unroll") for (int k = 0; k < 2; ++k) \
        acc[ai][bj][m][n] = __builtin_amdgcn_mfma_f32_16x16x32_bf16(Bt[n][k], At[m][k], acc[ai][bj][m][n], 0, 0, 0); __builtin_amdgcn_s_setprio(0); } while (0)
#define PG8_WAIT_V(n) asm volatile("s_waitcnt vmcnt(" #n ")" ::: "memory")
#define PG8_WAIT_L(n) asm volatile("s_waitcnt lgkmcnt(" #n ")" ::: "memory")
#define PG8_BAR __builtin_amdgcn_s_barrier()
#define PG8_SCHED __builtin_amdgcn_sched_barrier(0)
    Unit cur, nxt; int ui = 0;
    if (!S.next(0, cur)) return;
    f32x4 acc[2][2][4][2];
#pragma unroll
    for (int a = 0; a < 2; ++a)
#pragma unroll
        for (int b = 0; b < 2; ++b)
#pragma unroll
            for (int m = 0; m < 4; ++m)
#pragma unroll
                for (int n = 0; n < 2; ++n) acc[a][b][m][n] = (f32x4){0.f, 0.f, 0.f, 0.f};
    bf16x8 At[4][2], B0[2][2], B1[2][2];
    const char* cA = (const char*)g.A + (size_t)cur.pm * tstep; const char* cB = (const char*)g.Bt + (size_t)cur.pn * tstep;
    S.a_ready(cur);
    if constexpr (SP2) {
        PG8_STAGE(PG8_SB(0, 0), cB, voffB); PG8_STAGE(PG8_SB(0, 1), cB + hstep, voffB); PG8_STAGE(PG8_SA(0, 0), cA, voffA); PG8_STAGE(PG8_SA(0, 1), cA + hstep, voffA);
        if (wr == 1) PG8_BAR;
        PG8_WAIT_V(2); PG8_BAR;
        PG8_STAGE(PG8_SB(1, 0), cB + kstep, voffB); PG8_STAGE(PG8_SA(1, 0), cA + kstep, voffA); PG8_STAGE(PG8_SB(1, 1), cB + hstep + kstep, voffB);
        PG8_WAIT_V(6); PG8_BAR;
    } else {
        PG8_STAGE(PG8_SB(0, 0), cB, voffB); PG8_STAGE(PG8_SA(0, 0), cA, voffA); PG8_STAGE(PG8_SB(0, 1), cB + hstep, voffB); PG8_STAGE(PG8_SA(0, 1), cA + hstep, voffA);
        if (wr == 1) PG8_BAR;
        PG8_WAIT_V(4); PG8_BAR;
        PG8_STAGE(PG8_SB(1, 0), cB + kstep, voffB); PG8_STAGE(PG8_SA(1, 0), cA + kstep, voffA); PG8_STAGE(PG8_SB(1, 1), cB + hstep + kstep, voffB);
        PG8_WAIT_V(6); PG8_BAR;
    }
    for (;;) {
        const bool has_next = S.next(ui + 1, nxt);
        const char* nA = has_next ? (const char*)g.A + (size_t)nxt.pm * tstep : cA; const char* nB = has_next ? (const char*)g.Bt + (size_t)nxt.pn * tstep : cB;
        for (int t = 0; t < nt; t += 2) {
            const bool last = (t == nt - 2);
            const char* a1 = cA + (size_t)(t + 1) * kstep;
            const char* a2 = last ? nA : cA + (size_t)(t + 2) * kstep; const char* b2 = last ? nB : cB + (size_t)(t + 2) * kstep;
            const char* a3 = a2 + kstep; const char* b3 = b2 + kstep;
            if (last && has_next) S.a_ready(nxt);
            if constexpr (SP2) {
            PG8_LDB(B0, 0, 0); PG8_LDB(B1, 0, 1); PG8_SCHED; PG8_LDA(At, 0, 0); PG8_STAGE(PG8_SA(1, 1), a1 + hstep, voffA);
            PG8_WAIT_V(8); PG8_WAIT_L(0); PG8_BAR; PG8_MMA(0, 0, At, B0); PG8_MMA(0, 1, At, B1); PG8_BAR; PG8_SCHED;
            PG8_LDA(At, 0, 1); PG8_STAGE(PG8_SB(0, 0), b2, voffB); PG8_STAGE(PG8_SB(0, 1), b2 + hstep, voffB); PG8_STAGE(PG8_SA(0, 0), a2, voffA);
            PG8_WAIT_V(8); PG8_WAIT_L(0); PG8_BAR; PG8_MMA(1, 0, At, B0); PG8_MMA(1, 1, At, B1); PG8_BAR; PG8_SCHED;
            PG8_LDB(B0, 1, 0); PG8_LDB(B1, 1, 1); PG8_SCHED; PG8_LDA(At, 1, 0); PG8_STAGE(PG8_SA(0, 1), a2 + hstep, voffA);
            PG8_WAIT_V(8); PG8_WAIT_L(0); PG8_BAR; PG8_MMA(0, 0, At, B0); PG8_MMA(0, 1, At, B1); PG8_BAR; PG8_SCHED;
            PG8_LDA(At, 1, 1); PG8_STAGE(PG8_SB(1, 0), b3, voffB); PG8_STAGE(PG8_SB(1, 1), b3 + hstep, voffB); PG8_STAGE(PG8_SA(1, 0), a3, voffA);
            PG8_WAIT_V(8); PG8_WAIT_L(0); PG8_BAR; PG8_MMA(1, 0, At, B0); PG8_MMA(1, 1, At, B1); PG8_BAR; PG8_SCHED;
            } else {
            PG8_LDB(B0, 0, 0); PG8_SCHED; PG8_LDA(At, 0, 0); PG8_STAGE(PG8_SA(1, 1), a1 + hstep, voffA);
            PG8_WAIT_L(8); PG8_BAR; PG8_WAIT_L(0); PG8_MMA(0, 0, At, B0); PG8_BAR; PG8_SCHED;
            PG8_LDB(B1, 0, 1); PG8_STAGE(PG8_SB(0, 0), b2, voffB);
            PG8_BAR; PG8_WAIT_L(0); PG8_MMA(0, 1, At, B1); PG8_BAR;
            PG8_LDA(At, 0, 1); PG8_STAGE(PG8_SA(0, 0), a2, voffA);
            PG8_BAR; PG8_WAIT_L(0); PG8_MMA(1, 0, At, B0); PG8_BAR; PG8_SCHED;
            PG8_STAGE(PG8_SB(0, 1), b2 + hstep, voffB);
            PG8_WAIT_V(6); PG8_BAR; PG8_MMA(1, 1, At, B1); PG8_BAR;
            PG8_LDB(B0, 1, 0); PG8_SCHED; PG8_LDA(At, 1, 0); PG8_STAGE(PG8_SA(0, 1), a2 + hstep, voffA);
            PG8_WAIT_L(8); PG8_BAR; PG8_WAIT_L(0); PG8_MMA(0, 0, At, B0); PG8_BAR; PG8_SCHED;
            PG8_LDB(B1, 1, 1); PG8_STAGE(PG8_SB(1, 0), b3, voffB);
            PG8_BAR; PG8_WAIT_L(0); PG8_MMA(0, 1, At, B1); PG8_BAR;
            PG8_LDA(At, 1, 1); PG8_STAGE(PG8_SA(1, 0), a3, voffA);
            PG8_BAR; PG8_WAIT_L(0); PG8_MMA(1, 0, At, B0); PG8_BAR; PG8_SCHED;
            PG8_STAGE(PG8_SB(1, 1), b3 + hstep, voffB);
            PG8_WAIT_V(6); PG8_BAR; PG8_MMA(1, 1, At, B1); PG8_BAR;
            }
        }
        if constexpr (ALIGN_EPI) { if (wr == 0) PG8_BAR; }
        if constexpr (!Epi::AFTER_DRAIN) { E(acc, cur, wr, wc, fr, fq); S.done(cur); }
        if (!has_next) break;
#pragma unroll
        for (int a = 0; a < 2; ++a)
#pragma unroll
            for (int b = 0; b < 2; ++b)
#pragma unroll
                for (int m = 0; m < 4; ++m)
#pragma unroll
                    for (int n = 0; n < 2; ++n) acc[a][b][m][n] = (f32x4){0.f, 0.f, 0.f, 0.f};
        cur = nxt; cA = nA; cB = nB; ++ui;
        if constexpr (ALIGN_EPI) { if (wr == 1) PG8_BAR; }
    }
    PG8_WAIT_V(0);
    if constexpr (!ALIGN_EPI) { if (wr == 0) PG8_BAR; }
    PG8_BAR;
    if constexpr (Epi::AFTER_DRAIN) { E.fused(acc, cur, wr, wc, fr, fq, lds, wid, lane); S.done(cur); }
#undef PG8_SA
#undef PG8_SB
#undef PG8_STAGE
#undef PG8_LDA
#undef PG8_LDB
#undef PG8_MMA
#undef PG8_WAIT_V
#undef PG8_WAIT_L
#undef PG8_BAR
#undef PG8_SCHED
}
}

constexpr int DM = 1024, NB = 4, SEQ = 4096, RP = NB * SEQ, DBATCH = 128, DSEQ = 4, RS = DBATCH * DSEQ, RT = RP + RS;
constexpr int NH = 4, NG = 32, NMEM = 256, DFF = 2816, PASTLEN = 2048;
constexpr int RALL = RT + NB * NMEM;
constexpr float RMS_EPS = 1e-6f, LOG2E = 1.4426950408889634f;
constexpr float QSCALE = 0.125f * LOG2E;
constexpr float MSCALE = 0.0625f * LOG2E;
constexpr float LAM_INIT = 0.2f;
constexpr size_t O_YP = 0, O_YS = 16777216, O_KP = 17301504, O_VP = 25690112, O_KS = 34078720, O_VS = 34340864,
                 O_SRP = 34603008, O_SIP = 34611200, O_SRS = 34619392, O_SIS = 34881536, O_MKP = 35143680, O_MVP = 36192256, O_END = 37240832;
enum { I_XP = 0, I_XS, I_MEM, I_CK, I_CV, I_PT, I_SRE, I_SIM, I_CMK, I_CMV, I_GMIXPRE, I_GMIXPOST, I_WIN, I_LQ1, I_LK1, I_LQ2, I_LK2, I_GSUB,
       I_LAMRE, I_LAMIM, I_LOGDT, I_BRE, I_BIM, I_CRE, I_CIM, I_D, I_WGLU, I_GSSM, I_WOUT, I_GMEMPRE, I_GMEMPOST, I_GMEMKV, I_WMQ, I_WMK, I_WMV, I_WMO,
       I_GFFNPRE, I_GFFNPOST, I_WGATE, I_WUP, I_WDOWN, N_IN };

constexpr size_t MiB = 1u << 20;
constexpr size_t al(size_t x) { return (x + 4095) & ~(size_t)4095; }
constexpr size_t WS_CTL = 0, CTL_ZERO_BYTES = 2 * MiB;
constexpr int CW_BAR = 1024;
constexpr int CW_SSGLU = 8192, CW_SS1 = CW_SSGLU + RT, CW_SS2 = CW_SS1 + RT, CW_SS3 = CW_SS2 + RT, CW_RSUM = CW_SS3 + RT, CW_END = CW_RSUM + 65536;
static_assert((size_t)CW_END * 4 <= CTL_ZERO_BYTES, "ctl");
constexpr size_t WS_WIN = 2 * MiB;
constexpr size_t WS_WMKV = WS_WIN + (size_t)2048 * 1024 * 2;
constexpr size_t WS_WGLU = WS_WMKV + (size_t)2048 * 1024 * 2;
constexpr size_t WS_WOUT = WS_WGLU + (size_t)512 * 512 * 2;
constexpr size_t WS_WMQ = WS_WOUT + (size_t)1024 * 1024 * 2;
constexpr size_t WS_WMO = WS_WMQ + (size_t)1024 * 1024 * 2;
constexpr size_t WS_WGU = WS_WMO + (size_t)1024 * 1024 * 2;
constexpr size_t WS_WD = WS_WGU + (size_t)5632 * 1024 * 2;
constexpr size_t WS_MT = WS_WD + (size_t)1024 * 2816 * 2;
constexpr size_t WS_TF = WS_MT + (size_t)32 * 128 * 256 * 2;
constexpr size_t WS_SC = WS_TF + (size_t)32 * 256 * 384 * 2;
constexpr size_t SC_LB1 = 0, SC_LB16 = 4096, SC_LB512 = 8192, SC_BB = 12288, SC_MISC = SC_BB + 32 * 64 * 32, SC_FLOATS = SC_MISC + 64;
constexpr size_t WS_XN = al(WS_SC + SC_FLOATS * 4);
constexpr size_t WS_QB = al(WS_XN + (size_t)RALL * 1024 * 2);
constexpr size_t WS_KB = al(WS_QB + (size_t)RT * 512 * 2);
constexpr size_t WS_VB = al(WS_KB + (size_t)RT * 512 * 2);
constexpr size_t WS_US = al(WS_VB + (size_t)RT * 512 * 2);
constexpr size_t WS_XG = al(WS_US + (size_t)512 * 512 * 4);
constexpr size_t WS_G = al(WS_XG + (size_t)32 * 1024 * 384 * 2);
constexpr size_t WS_Z = al(WS_G + (size_t)RT * 512 * 2);
constexpr size_t WS_A2 = al(WS_Z + (size_t)RT * 512 * 4);
constexpr size_t WS_T = al(WS_A2 + (size_t)RT * 1024 * 2);
constexpr size_t WS_Y1 = al(WS_T + (size_t)RT * 1024 * 4);
constexpr size_t WS_Y2 = al(WS_Y1 + (size_t)RT * 1024 * 4);
constexpr size_t WS_A3 = al(WS_Y2 + (size_t)RT * 1024 * 4);
constexpr size_t WS_QH = al(WS_A3 + (size_t)RT * 1024 * 2);
constexpr size_t WS_QS = al(WS_QH + (size_t)16 * 4096 * 256 * 2);
constexpr size_t WS_MKH = al(WS_QS + (size_t)512 * 1024 * 4);
constexpr size_t WS_MVH = al(WS_MKH + (size_t)16 * 256 * 256 * 2);
constexpr size_t WS_MVT = al(WS_MVH + (size_t)16 * 256 * 256 * 2);
constexpr size_t WS_PM = al(WS_MVT + (size_t)16 * 256 * 256 * 2);
constexpr size_t WS_OM = al(WS_PM + (size_t)65536 * 256 * 2);
constexpr size_t WS_A4 = al(WS_OM + (size_t)RT * 1024 * 2);
constexpr size_t WS_H = al(WS_A4 + (size_t)RT * 1024 * 2);
constexpr size_t WS_END = al(WS_H + (size_t)RT * 2816 * 2);

constexpr int RING_BYTES = 131072, MISC_OFF = RING_BYTES + 320, LDS_BYTES = 147456;
constexpr int NWAVES = 8;

#define LAS __attribute__((address_space(3)))
typedef unsigned short bf16;
typedef unsigned u32x2 __attribute__((ext_vector_type(2)));
typedef unsigned u32x4 __attribute__((ext_vector_type(4)));
typedef float f32x4 __attribute__((ext_vector_type(4)));
typedef float f32x16 __attribute__((ext_vector_type(16)));
typedef short bf16x8 __attribute__((ext_vector_type(8)));
typedef float f32x2_t __attribute__((ext_vector_type(2))); typedef __bf16 bf16x2_t __attribute__((ext_vector_type(2)));
__device__ __forceinline__ unsigned pk2(float lo, float hi) { f32x2_t v = {lo, hi}; bf16x2_t b = __builtin_convertvector(v, bf16x2_t); return __builtin_bit_cast(unsigned, b); }
__device__ __forceinline__ float bflo(unsigned w) { return __uint_as_float(w << 16); }
__device__ __forceinline__ float bfhi(unsigned w) { return __uint_as_float(w & 0xffff0000u); }
__device__ __forceinline__ u32x4 pk8(const f32x4 a, const f32x4 b) { u32x4 w; w.x = pk2(a[0], a[1]); w.y = pk2(a[2], a[3]); w.z = pk2(b[0], b[1]); w.w = pk2(b[2], b[3]); return w; }
__device__ __forceinline__ float shx(float v, int k) {
    int l = __builtin_amdgcn_mbcnt_hi(-1, __builtin_amdgcn_mbcnt_lo(-1, 0)); asm volatile("" : "+v"(l));
    return __int_as_float(__builtin_amdgcn_ds_bpermute((l ^ k) << 2, __float_as_int(v)));
}
__device__ __forceinline__ float wave_sum(float v) {
    int l = __builtin_amdgcn_mbcnt_hi(-1, __builtin_amdgcn_mbcnt_lo(-1, 0)); asm volatile("" : "+v"(l));
#pragma unroll
    for (int o = 1; o < 64; o <<= 1) v += __int_as_float(__builtin_amdgcn_ds_bpermute((l ^ o) << 2, __float_as_int(v)));
    return v;
}
__device__ __forceinline__ float ex2(float x) { return __builtin_amdgcn_exp2f(x); }
__device__ __forceinline__ float sigmoidf_(float x) { return __builtin_amdgcn_rcpf(1.0f + ex2(-x * LOG2E)); }
__device__ __forceinline__ float gelu_tanh(float x) { const float z = 0.7978845608028654f * (x + 0.044715f * x * x * x); return x * __builtin_amdgcn_rcpf(1.0f + ex2(-2.0f * LOG2E * z)); }
__device__ __forceinline__ int crow(int r, int hi) { return (r & 3) + 8 * (r >> 2) + 4 * hi; }

#define XB_TMO      128
#define XB_XCNT(j)  (256  + 64 * (j))
#define XB_XSUB(j)  (1280 + 64 * (j))
#define XB_XGEN(j)  (2304 + 64 * (j))
#define XB_TOP      3328
#define XB_TOPGEN   3392
#define XCD_BAR_WORDS 3456
#define XB_SPIN_CAP (1u << 18)
__device__ __forceinline__ unsigned xb_ld(unsigned* p)              { return __hip_atomic_load(p, __ATOMIC_RELAXED, __HIP_MEMORY_SCOPE_AGENT); }
__device__ __forceinline__ unsigned xb_add(unsigned* p, unsigned v) { return __hip_atomic_fetch_add(p, v, __ATOMIC_RELAXED, __HIP_MEMORY_SCOPE_AGENT); }
__device__ __forceinline__ unsigned xb_xcc_id() { return (unsigned)__builtin_amdgcn_s_getreg((3 << 11) | 20) & 0xFu; }
#define XB_SPIN(cond, bar) do { unsigned _sp = 0; while (cond) { __builtin_amdgcn_s_sleep(1); \
    if ((++_sp & 255u) == 0u) { if (xb_ld(&(bar)[XB_TMO])) break; if (_sp > XB_SPIN_CAP) { atomicAdd(&(bar)[XB_TMO], 1u); break; } } } } while (0)
struct XcdBarrier { unsigned* bar; unsigned x; volatile LAS unsigned* st; };
__device__ __forceinline__ XcdBarrier xcd_barrier_post(unsigned* bar, volatile LAS unsigned* st) {
    XcdBarrier b; b.bar = bar; b.x = xb_xcc_id(); b.st = st;
    if (threadIdx.x == 0) (void)xb_add(&bar[XB_XCNT(b.x)], 1u);
    return b;
}
__device__ __forceinline__ void xcd_barrier_complete(unsigned* bar, unsigned x, unsigned& nloc, unsigned& nx) {
    const unsigned G = gridDim.x * gridDim.y * gridDim.z;
    unsigned sum, cnt, mine, sp = 0u;
    for (;;) {
        sum = 0u; cnt = 0u; mine = 0u;
#pragma unroll
        for (unsigned j = 0; j < 16; ++j) { const unsigned c = xb_ld(&bar[XB_XCNT(j)]); sum += c; cnt += (c > 0u) ? 1u : 0u; mine = (j == x) ? c : mine; }
        if (sum == G) break;
        __builtin_amdgcn_s_sleep(1);
        if ((++sp & 255u) == 0u) { if (xb_ld(&bar[XB_TMO])) break; if (sp > XB_SPIN_CAP) { atomicAdd(&bar[XB_TMO], 1u); break; } }
    }
    nloc = mine > 0u ? mine : 1u; nx = cnt > 0u ? cnt : 1u;
}
__device__ __forceinline__ void xcd_barrier(const XcdBarrier& b) {
    asm volatile("s_waitcnt vmcnt(0)" ::: "memory");
    __syncthreads();
    if (threadIdx.x == 0) {
        unsigned* bar = b.bar;
        __builtin_amdgcn_s_waitcnt(0);
        unsigned nloc = b.st[0], nx = b.st[1];
        if (nloc == 0u) { xcd_barrier_complete(bar, b.x, nloc, nx); b.st[0] = nloc; b.st[1] = nx; }
        const unsigned old = xb_add(&bar[XB_XSUB(b.x)], 1u);
        const unsigned gen = old / nloc;
        if (old + 1u == (gen + 1u) * nloc) {
            __builtin_amdgcn_fence(__ATOMIC_RELEASE, "agent");
            asm volatile("s_waitcnt vmcnt(0)" ::: "memory");
            const unsigned og = xb_add(&bar[XB_TOP], 1u);
            const unsigned tg = og / nx;
            if (og + 1u == (tg + 1u) * nx) xb_add(&bar[XB_TOPGEN], 1u);
            else XB_SPIN(xb_ld(&bar[XB_TOPGEN]) == tg, bar);
            __builtin_amdgcn_fence(__ATOMIC_ACQUIRE, "agent");
            xb_add(&bar[XB_XGEN(b.x)], 1u);
            asm volatile("s_waitcnt vmcnt(0)" ::: "memory");
        } else {
            XB_SPIN(xb_ld(&bar[XB_XGEN(b.x)]) == gen, bar);
            __builtin_amdgcn_fence(__ATOMIC_ACQUIRE, "agent");
            asm volatile("s_waitcnt vmcnt(0)" ::: "memory");
        }
    }
    __syncthreads();
}

struct KP {
    const float* in[N_IN]; float* out; unsigned char* ws;
};
#define WSP(T, off) ((T*)(P.ws + (off)))
#define CAS __attribute__((address_space(4)))
typedef const CAS KP& KPR;
__device__ __forceinline__ const CAS KP* kp_get() { const CAS KP* p = (const CAS KP*)__builtin_amdgcn_kernarg_segment_ptr(); asm volatile("" : "+s"(p)); return p; }

__device__ __forceinline__ void map_static(int L, int nM, int nN, pg8::Unit& u) {
    const int nwg = nM * nN; int wgid = L;
    { const int q = nwg / 8, r = nwg % 8, xcd = wgid % 8, off = wgid / 8; wgid = (xcd < r ? xcd * (q + 1) : r * (q + 1) + (xcd - r) * q) + off; }
    const int nig = 8 * nN, gid = wgid / nig, fm = gid * 8, gsz = (nM - fm) < 8 ? (nM - fm) : 8;
    u.pm = fm + ((wgid % nig) % gsz); u.pn = (wgid % nig) / gsz;
}
struct OrdStatic {
    int nM, nN, G, c;
    __device__ __forceinline__ bool next(int i, pg8::Unit& u) const { const long L = (long)i * G + c; if (L >= (long)nM * nN) return false; map_static((int)L, nM, nN, u); return true; }
    __device__ __forceinline__ void a_ready(const pg8::Unit&) const {}
    __device__ __forceinline__ void done(const pg8::Unit&) const {}
};
struct OrdInProj {
    int G, c;
    __device__ __forceinline__ bool next(int i, pg8::Unit& u) const {
        const long L = (long)i * G + c; if (L >= 560) return false;
        if (L < 528) map_static((int)L, 66, 8, u); else { const int e = (int)L - 528; u.pm = 66 + (e >> 3); u.pn = 8 + (e & 7); }
        return true; }
    __device__ __forceinline__ void a_ready(const pg8::Unit&) const {}
    __device__ __forceinline__ void done(const pg8::Unit&) const {}
};
struct OrdDiag {
    int n, sh, G, c;
    __device__ __forceinline__ bool next(int i, pg8::Unit& u) const { const long L = (long)i * G + c; if (L >= n) return false; u.pm = (int)L; u.pn = (int)L >> sh; return true; }
    __device__ __forceinline__ void a_ready(const pg8::Unit&) const {}
    __device__ __forceinline__ void done(const pg8::Unit&) const {}
};

#define EPI_ROWS(...) _Pragma("unroll") for (int ai = 0; ai < 2; ++ai) _Pragma("unroll") for (int m = 0; m < 4; ++m) { const int row_l = ai * 128 + wr * 64 + m * 16 + fr; __VA_ARGS__ __builtin_amdgcn_sched_barrier(0); }
#define EPI_COLS(...) _Pragma("unroll") for (int bj = 0; bj < 2; ++bj) { const int col_l = bj * 128 + wc * 32 + 8 * fq; const f32x4 v0 = acc[ai][bj][m][0], v1 = acc[ai][bj][m][1]; __VA_ARGS__ }

struct EpiInProj {
    static constexpr bool PERM = true, AFTER_DRAIN = false;
    float* out; bf16 *Qb, *Kb, *Vb, *Xg, *MKh, *MVh; float* Us;
    __device__ __forceinline__ void operator()(const f32x4 (&acc)[2][2][4][2], const pg8::Unit& u, int wr, int wc, int fr, int fq) const {
        const int pm = u.pm, pn = u.pn;
        float* of = nullptr; bf16* ob = nullptr; int ldf = 512, ldb = 512; float sc = 1.0f;
        if (pm < 66) {
            const int sect = pn >> 1, cbase = (pn & 1) * 256;
            if (sect == 0) { ob = Qb + (size_t)pm * 256 * 512 + cbase; sc = QSCALE; }
            else if (sect == 1) { ob = Kb + (size_t)pm * 256 * 512 + cbase; of = ((pm < 64) ? out + O_KP + (size_t)pm * 256 * 512 : out + O_KS + (size_t)(pm - 64) * 256 * 512) + cbase; }
            else if (sect == 2) { ob = Vb + (size_t)pm * 256 * 512 + cbase; of = ((pm < 64) ? out + O_VP + (size_t)pm * 256 * 512 : out + O_VS + (size_t)(pm - 64) * 256 * 512) + cbase; }
            else if (pm >= 64) { of = Us + (size_t)(pm - 64) * 256 * 512 + cbase; }
            if (sect == 3 && pm < 64) {
                EPI_ROWS( const int row = pm * 256 + row_l;
                    EPI_COLS( const int c512 = cbase + col_l, g = c512 >> 4, ch = c512 & 15;
                        *(u32x4*)(Xg + ((size_t)g * 1024 + (row >> 4)) * 384 + (row & 15) * 16 + ch) = pk8(v0, v1); ) )
                return;
            }
        } else {
            const int b = pm - 66, hs = pn - 8, h = hs & 3;
            of = out + (hs < 4 ? O_MKP : O_MVP) + (size_t)b * 256 * 1024 + h * 256; ldf = 1024;
            ob = (hs < 4 ? MKh : MVh) + (size_t)(b * 4 + h) * 256 * 256; ldb = 256;
        }
        if (of) { EPI_ROWS( EPI_COLS( float* o = of + (size_t)row_l * ldf + col_l; *(f32x4*)o = v0; *(f32x4*)(o + 4) = v1; ) ) }
        if (ob) { EPI_ROWS( EPI_COLS( *(u32x4*)(ob + (size_t)row_l * ldb + col_l) = pk8(v0 * sc, v1 * sc); ) ) }
    }
};

struct EpiS3 {
    static constexpr bool PERM = true, AFTER_DRAIN = false;
    bf16* G;
    __device__ __forceinline__ void operator()(const f32x4 (&acc)[2][2][4][2], const pg8::Unit& u, int wr, int wc, int fr, int fq) const {
        const int g = u.pn, panel = u.pm & 3;
        EPI_ROWS(
            const int chunk = panel * 256 + row_l;
            EPI_COLS(
                const int s = col_l >> 4, hh = col_l & 15;
                f32x4 a, b;
_Pragma("unroll")
                for (int i = 0; i < 4; ++i) { a[i] = gelu_tanh(v0[i]); b[i] = gelu_tanh(v1[i]); }
                *(u32x4*)(G + ((size_t)chunk * 16 + s) * 512 + g * 16 + hh) = pk8(a, b);
            )
        )
    }
};

struct EpiGlu {
    static constexpr bool PERM = true, AFTER_DRAIN = false;
    const bf16* G; float* Z; float* ss;
    __device__ __forceinline__ void operator()(const f32x4 (&acc)[2][2][4][2], const pg8::Unit& u, int wr, int wc, int fr, int fq) const {
        EPI_ROWS(
            const int row = u.pm * 256 + row_l; float q = 0.f;
            EPI_COLS(
                const int col = u.pn * 256 + col_l;
                const u32x4 yw = *(const u32x4*)(G + (size_t)row * 512 + col);
                f32x4 a, b;
                a[0] = bflo(yw.x) * sigmoidf_(v0[0]); a[1] = bfhi(yw.x) * sigmoidf_(v0[1]); a[2] = bflo(yw.y) * sigmoidf_(v0[2]); a[3] = bfhi(yw.y) * sigmoidf_(v0[3]);
                b[0] = bflo(yw.z) * sigmoidf_(v1[0]); b[1] = bfhi(yw.z) * sigmoidf_(v1[1]); b[2] = bflo(yw.w) * sigmoidf_(v1[2]); b[3] = bfhi(yw.w) * sigmoidf_(v1[3]);
                float* o = Z + (size_t)row * 512 + col; *(f32x4*)o = a; *(f32x4*)(o + 4) = b;
                q += (a[0] * a[0] + a[1] * a[1]) + (a[2] * a[2] + a[3] * a[3]) + (b[0] * b[0] + b[1] * b[1]) + (b[2] * b[2] + b[3] * b[3]);
            )
            q += shx(q, 16); q += shx(q, 32);
            if (fq == 0) __hip_atomic_fetch_add(ss + row, q, __ATOMIC_RELAXED, __HIP_MEMORY_SCOPE_AGENT);
        )
    }
};

struct EpiF32SS {
    static constexpr bool PERM = true, AFTER_DRAIN = false;
    float* T; float* ss;
    __device__ __forceinline__ void operator()(const f32x4 (&acc)[2][2][4][2], const pg8::Unit& u, int wr, int wc, int fr, int fq) const {
        EPI_ROWS(
            const int row = u.pm * 256 + row_l; float q = 0.f;
            EPI_COLS(
                float* o = T + (size_t)row * 1024 + u.pn * 256 + col_l; *(f32x4*)o = v0; *(f32x4*)(o + 4) = v1;
                q += (v0[0] * v0[0] + v0[1] * v0[1]) + (v0[2] * v0[2] + v0[3] * v0[3]) + (v1[0] * v1[0] + v1[1] * v1[1]) + (v1[2] * v1[2] + v1[3] * v1[3]);
            )
            q += shx(q, 16); q += shx(q, 32);
            if (fq == 0) __hip_atomic_fetch_add(ss + row, q, __ATOMIC_RELAXED, __HIP_MEMORY_SCOPE_AGENT);
        )
    }
};

struct EpiMq {
    static constexpr bool PERM = true, AFTER_DRAIN = false;
    bf16* Qh; float* Qs;
    __device__ __forceinline__ void operator()(const f32x4 (&acc)[2][2][4][2], const pg8::Unit& u, int wr, int wc, int fr, int fq) const {
        const int pm = u.pm, h = u.pn;
        EPI_ROWS(
            EPI_COLS(
                if (pm < 64) {
                    const int b = pm >> 4, t = (pm & 15) * 256 + row_l;
                    *(u32x4*)(Qh + ((size_t)(b * 4 + h) * 4096 + t) * 256 + col_l) = pk8(v0 * MSCALE, v1 * MSCALE);
                } else {
                    float* o = Qs + (size_t)((pm - 64) * 256 + row_l) * 1024 + h * 256 + col_l;
                    *(f32x4*)o = v0 * MSCALE; *(f32x4*)(o + 4) = v1 * MSCALE;
                }
            )
        )
    }
};

struct EpiMemQK {
    static constexpr bool PERM = true, AFTER_DRAIN = false;
    bf16* Pm; float* rsum;
    __device__ __forceinline__ void operator()(const f32x4 (&acc)[2][2][4][2], const pg8::Unit& u, int wr, int wc, int fr, int fq) const {
        EPI_ROWS(
            const int prow = u.pm * 256 + row_l; float q = 0.f;
            EPI_COLS(
                f32x4 a, b;
_Pragma("unroll")
                for (int i = 0; i < 4; ++i) { a[i] = ex2(fminf(v0[i], 100.f)); b[i] = ex2(fminf(v1[i], 100.f)); }
                *(u32x4*)(Pm + (size_t)prow * 256 + col_l) = pk8(a, b);
                q += (a[0] + a[1]) + (a[2] + a[3]) + (b[0] + b[1]) + (b[2] + b[3]);
            )
            q += shx(q, 16); q += shx(q, 32);
            if (fq == 0) __hip_atomic_fetch_add(rsum + prow, q, __ATOMIC_RELAXED, __HIP_MEMORY_SCOPE_AGENT);
        )
    }
};

struct EpiMemPV {
    static constexpr bool PERM = true, AFTER_DRAIN = false;
    bf16* Om; const float* rsum;
    __device__ __forceinline__ void operator()(const f32x4 (&acc)[2][2][4][2], const pg8::Unit& u, int wr, int wc, int fr, int fq) const {
        const int bh = u.pn, b = bh >> 2, h = bh & 3, panel = u.pm & 15;
        EPI_ROWS(
            const int prow = u.pm * 256 + row_l; const float inv = 1.0f / rsum[prow];
            const int row = b * 4096 + panel * 256 + row_l;
            EPI_COLS(
                *(u32x4*)(Om + (size_t)row * 1024 + h * 256 + col_l) = pk8(v0 * inv, v1 * inv);
            )
        )
    }
};

struct EpiSwiglu {
    static constexpr bool PERM = true, AFTER_DRAIN = false;
    bf16* H;
    __device__ __forceinline__ void operator()(const f32x4 (&acc)[2][2][4][2], const pg8::Unit& u, int wr, int wc, int fr, int fq) const {
        EPI_ROWS(
            const int row = u.pm * 256 + row_l;
            f32x4 a, b;
_Pragma("unroll")
            for (int i = 0; i < 4; ++i) {
                const float g0 = acc[ai][0][m][0][i], g1 = acc[ai][0][m][1][i];
                a[i] = g0 * sigmoidf_(g0) * acc[ai][1][m][0][i]; b[i] = g1 * sigmoidf_(g1) * acc[ai][1][m][1][i]; }
            *(u32x4*)(H + (size_t)row * 2816 + u.pn * 128 + wc * 32 + 8 * fq) = pk8(a, b);
        )
    }
};

__device__ __forceinline__ void p0_transpose_item(const float* W, int K, int N, bf16* WT, int drow0, LAS float* scr, int k0, int n0, int lane) {
#pragma unroll 8
    for (int i = 0; i < 32; ++i) { const int kk = 2 * i + (lane >> 5); scr[kk * 33 + (lane & 31)] = W[(size_t)(k0 + kk) * N + n0 + (lane & 31)]; }
    asm volatile("s_waitcnt lgkmcnt(0)" ::: "memory");
    const int c = lane & 7;
#pragma unroll
    for (int jj = 0; jj < 4; ++jj) { const int n = (lane >> 3) + 8 * jj; const LAS float* s = scr + (8 * c) * 33 + n;
        u32x4 o; o.x = pk2(s[0 * 33], s[1 * 33]); o.y = pk2(s[2 * 33], s[3 * 33]); o.z = pk2(s[4 * 33], s[5 * 33]); o.w = pk2(s[6 * 33], s[7 * 33]);
        *(u32x4*)(WT + (size_t)(drow0 + n) * K + k0 + 8 * c) = o; }
    asm volatile("s_waitcnt lgkmcnt(0)" ::: "memory");
}
__device__ __forceinline__ void rms_row_to_bf16(const float* xrow, const float* gain, bf16* orow, int lane) {
    const f32x4* xr = (const f32x4*)xrow + lane; const f32x4* gr = (const f32x4*)gain + lane;
    f32x4 v[4]; float s = 0.f;
#pragma unroll
    for (int jj = 0; jj < 4; ++jj) { v[jj] = xr[64 * jj]; s += (v[jj].x * v[jj].x + v[jj].y * v[jj].y) + (v[jj].z * v[jj].z + v[jj].w * v[jj].w); }
    const float r = 1.0f / sqrtf(wave_sum(s) * (1.f / 1024.f) + RMS_EPS);
    unsigned long long* o8 = (unsigned long long*)orow + lane;
#pragma unroll
    for (int jj = 0; jj < 4; ++jj) { const f32x4 g = gr[64 * jj]; o8[64 * jj] = (unsigned long long)pk2(v[jj].x * r * g.x, v[jj].y * r * g.y) | ((unsigned long long)pk2(v[jj].z * r * g.z, v[jj].w * r * g.w) << 32); }
}

__device__ __forceinline__ void ssm_consts_group(KPR P, LAS unsigned char* lds, int g, int tid) {
    LAS float* Pre = (LAS float*)lds;
    LAS float* Pim = Pre + 17 * 64;
    LAS float* bbr = Pim + 17 * 64;
    LAS float* bbi = bbr + 64 * 16;
    LAS float* Kd = bbi + 64 * 16;
    float* SC = WSP(float, WS_SC);
    const float* lam_re = P.in[I_LAMRE] + g * 64; const float* lam_im = P.in[I_LAMIM] + g * 64;
    const float* b_re = P.in[I_BRE] + (size_t)g * 64 * 16; const float* b_im = P.in[I_BIM] + (size_t)g * 64 * 16;
    const float* c_re = P.in[I_CRE] + (size_t)g * 16 * 64; const float* c_im = P.in[I_CIM] + (size_t)g * 16 * 64;
    const float* dsk = P.in[I_D] + g * 16;
    if (tid < 64) {
        const int p = tid;
        const float dt = expf(P.in[I_LOGDT][g]);
        const float lr = lam_re[p], li = lam_im[p];
        const float a = lr * dt;
        const double thd = (double)li * (double)dt;
        const double k2 = __builtin_rint(thd * 0.15915494309189535);
        const float th = (float)(thd - k2 * 6.283185307179586);
        const float ea = expf(a), cs = cosf(th), sn = sinf(th), sh = sinf(0.5f * th);
        const float lbr = ea * cs, lbi = ea * sn;
        float pr = 1.f, pi = 0.f;
        Pre[p] = 1.f; Pim[p] = 0.f;
        for (int d = 1; d <= 16; ++d) { const float nr = pr * lbr - pi * lbi, ni = pr * lbi + pi * lbr; pr = nr; pi = ni; Pre[d * 64 + p] = pr; Pim[d * 64 + p] = pi; }
        const float nr_ = expm1f(a) * cs - 2.f * sh * sh, ni_ = lbi;
        const float inv = 1.0f / (lr * lr + li * li);
        const float fr_ = (nr_ * lr + ni_ * li) * inv, fi_ = (ni_ * lr - nr_ * li) * inv;
        for (int h = 0; h < 16; ++h) { const float br = b_re[p * 16 + h], bi = b_im[p * 16 + h];
            const float xr = fr_ * br - fi_ * bi, xi = fr_ * bi + fi_ * br;
            bbr[p * 16 + h] = xr; bbi[p * 16 + h] = xi;
            SC[SC_BB + ((size_t)(g * 64 + p) * 16 + h) * 2] = xr; SC[SC_BB + ((size_t)(g * 64 + p) * 16 + h) * 2 + 1] = xi; }
        SC[SC_LB1 + (g * 64 + p) * 2] = lbr; SC[SC_LB1 + (g * 64 + p) * 2 + 1] = lbi;
        SC[SC_LB16 + (g * 64 + p) * 2] = pr; SC[SC_LB16 + (g * 64 + p) * 2 + 1] = pi;
        float qr = pr, qi = pi;
        for (int k = 0; k < 5; ++k) { const float nr = qr * qr - qi * qi, ni = 2.f * qr * qi; qr = nr; qi = ni; }
        SC[SC_LB512 + (g * 64 + p) * 2] = qr; SC[SC_LB512 + (g * 64 + p) * 2 + 1] = qi;
    }
    __syncthreads();
    for (int e = tid; e < 4096; e += 512) {
        const int d = e >> 8, hh = (e >> 4) & 15, h = e & 15; float s = 0.f;
        for (int p = 0; p < 64; ++p) {
            const float cr = c_re[hh * 64 + p], ci = c_im[hh * 64 + p], wr_ = Pre[d * 64 + p], wi_ = Pim[d * 64 + p];
            const float tr = cr * wr_ - ci * wi_, ti = cr * wi_ + ci * wr_;
            s += tr * bbr[p * 16 + h] - ti * bbi[p * 16 + h]; }
        Kd[e] = s; }
    bf16* Mt = WSP(bf16, WS_MT) + (size_t)g * 128 * 256;
    for (int e = tid; e < 128 * 256; e += 512) {
        const int n = e >> 8, k = e & 255, p = n & 63, sp = k >> 4, h = k & 15;
        const float wr_ = Pre[(15 - sp) * 64 + p], wi_ = Pim[(15 - sp) * 64 + p], br = bbr[p * 16 + h], bi = bbi[p * 16 + h];
        const float v = (n < 64) ? (wr_ * br - wi_ * bi) : (wr_ * bi + wi_ * br);
        Mt[e] = (bf16)(pk2(v, 0.f) & 0xffffu); }
    __syncthreads();
    bf16* TF = WSP(bf16, WS_TF) + (size_t)g * 256 * 384;
    for (int e = tid; e < 256 * 384; e += 512) {
        const int n = e / 384, k = e - n * 384, s = n >> 4, hh = n & 15; float v;
        if (k < 256) { const int sp = k >> 4, h = k & 15; v = (sp <= s) ? Kd[((s - sp) << 8) + (hh << 4) + h] + ((sp == s && h == hh) ? dsk[hh] : 0.f) : 0.f; }
        else { const int p = (k - 256) & 63; const float cr = c_re[hh * 64 + p], ci = c_im[hh * 64 + p], wr_ = Pre[(s + 1) * 64 + p], wi_ = Pim[(s + 1) * 64 + p];
            v = (k < 320) ? (cr * wr_ - ci * wi_) : -(cr * wi_ + ci * wr_); }
        TF[e] = (bf16)(pk2(v, 0.f) & 0xffffu); }
    __syncthreads();
}

__device__ __forceinline__ void p0_prologue(KPR P, LAS unsigned char* lds, int vcu, int G, int tid, int wave, int lane) {
    if (vcu < NG) ssm_consts_group(P, lds, vcu, tid);
    else if (G < NG + 1) { for (int g = 0; g < NG; ++g) if (vcu == 0) ssm_consts_group(P, lds, g, tid); }
    if (blockIdx.x == 0 && wave == 0) {
        const float a = wave_sum(P.in[I_LQ1][lane] * P.in[I_LK1][lane]), b = wave_sum(P.in[I_LQ2][lane] * P.in[I_LK2][lane]);
        if (lane == 0) WSP(float, WS_SC)[SC_MISC] = expf(a) - expf(b) + LAM_INIT;
    }
    LAS float* scr = (LAS float*)(lds + wave * 16384);
    const int gw = vcu * NWAVES + wave, NGW = G * NWAVES;
    constexpr int I_IN = 16 * 64, I_GLU = 8 * 16, I_SQ = 16 * 32, I_GU = 16 * 88, I_DN = 44 * 32;
    constexpr int NITEMS = I_IN + I_GLU + 5 * I_SQ + 2 * I_GU + I_DN;
    for (int it = gw; it < NITEMS; it += NGW) {
        int r = it;
        if (r < I_IN) { const int kb = r / 64, nb = r % 64; p0_transpose_item(P.in[I_WIN], 1024, 2048, WSP(bf16, WS_WIN), nb * 32, scr, kb * 64, nb * 32, lane); continue; } r -= I_IN;
        if (r < I_GLU) { const int kb = r / 16, nb = r % 16; p0_transpose_item(P.in[I_WGLU], 512, 512, WSP(bf16, WS_WGLU), nb * 32, scr, kb * 64, nb * 32, lane); continue; } r -= I_GLU;
        if (r < 5 * I_SQ) { const int w = r / I_SQ, rr = r % I_SQ, kb = rr / 32, nb = rr % 32;
            const float* W = w == 0 ? P.in[I_WOUT] : w == 1 ? P.in[I_WMQ] : w == 2 ? P.in[I_WMK] : w == 3 ? P.in[I_WMV] : P.in[I_WMO];
            bf16* D = w == 0 ? WSP(bf16, WS_WOUT) : w == 1 ? WSP(bf16, WS_WMQ) : w == 2 ? WSP(bf16, WS_WMKV) : w == 3 ? WSP(bf16, WS_WMKV) + (size_t)1024 * 1024 : WSP(bf16, WS_WMO);
            p0_transpose_item(W, 1024, 1024, D, nb * 32, scr, kb * 64, nb * 32, lane); continue; } r -= 5 * I_SQ;
        if (r < 2 * I_GU) { const int w = r / I_GU, rr = r % I_GU, kb = rr / 88, nb = rr % 88, n0 = nb * 32;
            p0_transpose_item(w == 0 ? P.in[I_WGATE] : P.in[I_WUP], 1024, 2816, WSP(bf16, WS_WGU), 256 * (n0 >> 7) + 128 * w + (n0 & 127), scr, kb * 64, n0, lane); continue; } r -= 2 * I_GU;
        { const int kb = r / 32, nb = r % 32; p0_transpose_item(P.in[I_WDOWN], 2816, 1024, WSP(bf16, WS_WD), nb * 32, scr, kb * 64, nb * 32, lane); }
    }
    bf16* XN = WSP(bf16, WS_XN);
    for (int m = gw; m < RALL; m += NGW) {
        const float* xr = (m < RP) ? P.in[I_XP] + (size_t)m * 1024 : (m < RT) ? P.in[I_XS] + (size_t)(m - RP) * 1024 : P.in[I_MEM] + (size_t)(m - RT) * 1024;
        rms_row_to_bf16(xr, (m < RT) ? P.in[I_GMIXPRE] : P.in[I_GMEMKV], XN + (size_t)m * 1024, lane);
    }
}

#define MFMA32(a, b, c) __builtin_amdgcn_mfma_f32_32x32x16_bf16((a), (b), (c), 0, 0, 0)
constexpr int AT_KSTR = 272, AT_VSTR = 320, AT_KTILE = 64 * AT_KSTR, AT_VTILE = 64 * AT_VSTR;
constexpr int AT_KOFF = 0, AT_VOFF = 2 * AT_KTILE;
typedef short v4i16_t __attribute__((ext_vector_type(4)));
__device__ __forceinline__ u32x2 vtr(const LAS unsigned char* p) { return __builtin_bit_cast(u32x2, __builtin_amdgcn_ds_read_tr16_b64_v4i16((LAS v4i16_t*)p)); }

#define SOFTMAX_BLOCK(x, m, l, oT, pf0, pf1) do { \
    float mx_ = fmaxf(fmaxf(fmaxf(x[0], x[1]), fmaxf(x[2], x[3])), fmaxf(fmaxf(x[4], x[5]), fmaxf(x[6], x[7]))); \
    mx_ = fmaxf(mx_, fmaxf(fmaxf(fmaxf(x[8], x[9]), fmaxf(x[10], x[11])), fmaxf(fmaxf(x[12], x[13]), fmaxf(x[14], x[15])))); \
    mx_ = fmaxf(mx_, shx(mx_, 32)); \
    const float mn_ = fmaxf(m, mx_); \
    if (!__all(mn_ == m)) { const float al_ = ex2(m - mn_); l *= al_; \
        _Pragma("unroll") for (int eb_ = 0; eb_ < 4; ++eb_) _Pragma("unroll") for (int r_ = 0; r_ < 16; ++r_) oT[eb_][r_] *= al_; \
        m = mn_; } \
    float ps_ = 0.f; \
    _Pragma("unroll") for (int r_ = 0; r_ < 16; ++r_) { x[r_] = ex2(x[r_] - m); ps_ += x[r_]; } \
    l += ps_; \
    pf0 = __builtin_bit_cast(bf16x8, (u32x4){pk2(x[0], x[1]), pk2(x[2], x[3]), pk2(x[4], x[5]), pk2(x[6], x[7])}); \
    pf1 = __builtin_bit_cast(bf16x8, (u32x4){pk2(x[8], x[9]), pk2(x[10], x[11]), pk2(x[12], x[13]), pk2(x[14], x[15])}); \
} while (0)

__device__ __forceinline__ void attn_prompt_unit(KPR P, LAS unsigned char* lds, int b, int h, int qb, float lam, int tid, int wave, int lane) {
    const int j = lane & 31, hi = lane >> 5, c = wave >> 2, wq = wave & 3;
    const int q0 = qb * 128 + wq * 32, qpos = q0 + j;
    const bf16* Qp = WSP(bf16, WS_QB) + ((size_t)(b * 4096 + q0 + j)) * 512 + h * 128 + c * 64 + 8 * hi;
    bf16x8 qf[4];
#pragma unroll
    for (int s = 0; s < 4; ++s) qf[s] = *(const bf16x8*)(Qp + 16 * s);
    f32x16 oT[4];
#pragma unroll
    for (int eb = 0; eb < 4; ++eb)
#pragma unroll
        for (int r = 0; r < 16; ++r) oT[eb][r] = 0.f;
    float m = -1e30f, l = 0.f;
    const float slope2 = ex2(-2.0f * (float)(h + 1)) * LOG2E;
    const int nkt = 2 * (qb + 1);
    const bf16* Kg = WSP(bf16, WS_KB) + ((size_t)b * 4096) * 512 + h * 128;
    const bf16* Vg = WSP(bf16, WS_VB) + ((size_t)b * 4096) * 512 + h * 128;
    const int kkey0 = tid >> 4, kch = tid & 15;
    u32x4 kr0, kr1, vr0, vr1;
#define AT_LOADREGS(kt) do { \
        kr0 = *(const u32x4*)(Kg + (size_t)((kt) * 64 + kkey0) * 512 + kch * 8); kr1 = *(const u32x4*)(Kg + (size_t)((kt) * 64 + kkey0 + 32) * 512 + kch * 8); \
        vr0 = *(const u32x4*)(Vg + (size_t)((kt) * 64 + kkey0) * 512 + kch * 8); vr1 = *(const u32x4*)(Vg + (size_t)((kt) * 64 + kkey0 + 32) * 512 + kch * 8); } while (0)
#define AT_WRITELDS(buf) do { \
        *(LAS u32x4*)(lds + AT_KOFF + (buf) * AT_KTILE + kkey0 * AT_KSTR + kch * 16) = kr0; *(LAS u32x4*)(lds + AT_KOFF + (buf) * AT_KTILE + (kkey0 + 32) * AT_KSTR + kch * 16) = kr1; \
        *(LAS u32x4*)(lds + AT_VOFF + (buf) * AT_VTILE + kkey0 * AT_VSTR + kch * 16) = vr0; *(LAS u32x4*)(lds + AT_VOFF + (buf) * AT_VTILE + (kkey0 + 32) * AT_VSTR + kch * 16) = vr1; } while (0)
    AT_LOADREGS(0); AT_WRITELDS(0);
    __syncthreads();
    for (int kt = 0; kt < nkt; ++kt) {
        const int buf = kt & 1;
        if (kt + 1 < nkt) AT_LOADREGS(kt + 1);
#pragma unroll
        for (int blk = 0; blk < 2; ++blk) {
            const int kb = kt * 64 + blk * 32;
            if (kb > q0 + 31) continue;
            f32x16 s;
#pragma unroll
            for (int r = 0; r < 16; ++r) s[r] = 0.f;
            const LAS unsigned char* kp = lds + AT_KOFF + buf * AT_KTILE + (blk * 32 + j) * AT_KSTR + c * 128 + hi * 16;
#pragma unroll
            for (int s4 = 0; s4 < 4; ++s4) { const bf16x8 kf = *(const LAS bf16x8*)(kp + s4 * 32); s = MFMA32(kf, qf[s4], s); }
            float x[16];
            const float base = slope2 * (float)(kb + 4 * hi - qpos);
#pragma unroll
            for (int r = 0; r < 16; ++r) x[r] = s[r] + (base + slope2 * (float)((r & 3) + 8 * (r >> 2)));
            if (kb + 31 > q0) {
#pragma unroll
                for (int r = 0; r < 16; ++r) if (kb + crow(r, hi) > qpos) x[r] = -INFINITY;
            }
            bf16x8 pf0, pf1;
            SOFTMAX_BLOCK(x, m, l, oT, pf0, pf1);
#pragma unroll
            for (int eb = 0; eb < 4; ++eb) {
                const LAS unsigned char* vp = lds + AT_VOFF + buf * AT_VTILE + (blk * 32 + 4 * hi + ((lane & 15) >> 2)) * AT_VSTR + (eb * 32 + 16 * ((lane >> 4) & 1) + 4 * (lane & 3)) * 2;
                const u32x2 a0 = vtr(vp), a1 = vtr(vp + 8 * AT_VSTR), b0 = vtr(vp + 16 * AT_VSTR), b1 = vtr(vp + 24 * AT_VSTR);
                oT[eb] = MFMA32(__builtin_bit_cast(bf16x8, (u32x4){a0.x, a0.y, a1.x, a1.y}), pf0, oT[eb]);
                oT[eb] = MFMA32(__builtin_bit_cast(bf16x8, (u32x4){b0.x, b0.y, b1.x, b1.y}), pf1, oT[eb]);
            }
        }
        if (kt + 1 < nkt) AT_WRITELDS(buf ^ 1);
        __syncthreads();
    }
#undef AT_LOADREGS
#undef AT_WRITELDS
    l += shx(l, 32);
    const float inv = 1.0f / l;
    LAS float* C = (LAS float*)lds;
    if (c == 1) {
#pragma unroll
        for (int eb = 0; eb < 4; ++eb)
#pragma unroll
            for (int r = 0; r < 16; ++r) C[(wq * 128 + eb * 32 + crow(r, hi)) * 32 + j] = oT[eb][r] * inv;
    }
    __syncthreads();
    if (c == 0) {
        float ss = 0.f;
#pragma unroll
        for (int eb = 0; eb < 4; ++eb)
#pragma unroll
            for (int r = 0; r < 16; ++r) { const float d = oT[eb][r] * inv - lam * C[(wq * 128 + eb * 32 + crow(r, hi)) * 32 + j]; oT[eb][r] = d; ss += d * d; }
        ss += shx(ss, 32);
        const float rn = (1.0f - LAM_INIT) / sqrtf(ss * (1.f / 128.f) + RMS_EPS);
        const float* gs = P.in[I_GSUB];
        bf16* op = WSP(bf16, WS_A2) + ((size_t)(b * 4096 + q0 + j)) * 1024 + h * 128;
#pragma unroll
        for (int eb = 0; eb < 4; ++eb)
#pragma unroll
            for (int k4 = 0; k4 < 4; ++k4) { const int e = eb * 32 + 8 * k4 + 4 * hi; const f32x4 g4 = *(const f32x4*)(gs + e);
                *(u32x2*)(op + e) = (u32x2){pk2(oT[eb][4 * k4] * rn * g4[0], oT[eb][4 * k4 + 1] * rn * g4[1]), pk2(oT[eb][4 * k4 + 2] * rn * g4[2], oT[eb][4 * k4 + 3] * rn * g4[3])}; }
    }
    __syncthreads();
}

__device__ __forceinline__ void attn_sample_unit(KPR P, LAS unsigned char* lds, int db, int h, float lam, int tid, int wave, int lane) {
    const int j = lane & 31, hi = lane >> 5, q = j & 3, cj = (j >> 2) & 1;
    bf16x8 qf[8];
    {
        const bf16* Qp = WSP(bf16, WS_QB) + ((size_t)(RP + db * 4 + q)) * 512 + h * 128 + cj * 64 + 8 * hi;
#pragma unroll
        for (int s = 0; s < 8; ++s) { bf16x8 v = *(const bf16x8*)(Qp + 16 * (s & 3)); if (!(j < 8 && (s >> 2) == cj)) v = (bf16x8){0, 0, 0, 0, 0, 0, 0, 0}; qf[s] = v; }
    }
    f32x16 oT[4];
#pragma unroll
    for (int eb = 0; eb < 4; ++eb)
#pragma unroll
        for (int r = 0; r < 16; ++r) oT[eb][r] = 0.f;
    float m = -1e30f, l = 0.f;
    const float slope2 = ex2(-2.0f * (float)(h + 1)) * LOG2E;
    const int qpos = PASTLEN + q;
    const int* pt = (const int*)P.in[I_PT] + db * 16;
    const int nblk = (wave == 7) ? 9 : 8;
    for (int ib = 0; ib < nblk; ++ib) {
        const bool newblk = (ib == 8);
        const int kpos0 = newblk ? PASTLEN : wave * 256 + ib * 32;
        const float* kbase; const float* vbase; int nvalid;
        if (!newblk) { const int pg = pt[kpos0 >> 7]; const size_t ro = ((size_t)(pg * 128 + (kpos0 & 127)) * 4 + h) * 128; kbase = P.in[I_CK] + ro; vbase = P.in[I_CV] + ro; nvalid = 32; }
        else { const size_t ro = (size_t)(db * 4) * 512 + h * 128; kbase = P.out + O_KS + ro; vbase = P.out + O_VS + ro; nvalid = 4; }
        f32x16 s;
#pragma unroll
        for (int r = 0; r < 16; ++r) s[r] = 0.f;
        {
            const float* kp = kbase + (size_t)(j < nvalid ? j : nvalid - 1) * 512 + 8 * hi;
#pragma unroll
            for (int s8 = 0; s8 < 8; ++s8) { const f32x4 a = *(const f32x4*)(kp + 16 * s8), bq = *(const f32x4*)(kp + 16 * s8 + 4);
                s = MFMA32(__builtin_bit_cast(bf16x8, pk8(a, bq)), qf[s8], s); }
        }
        float x[16];
        const float base = slope2 * (float)(kpos0 + 4 * hi - qpos);
#pragma unroll
        for (int r = 0; r < 16; ++r) x[r] = s[r] + (base + slope2 * (float)((r & 3) + 8 * (r >> 2)));
        if (newblk) {
#pragma unroll
            for (int r = 0; r < 16; ++r) { const int kl = crow(r, hi); if (kl >= 4 || kl > q) x[r] = -INFINITY; }
        }
        bf16x8 pf0, pf1;
        SOFTMAX_BLOCK(x, m, l, oT, pf0, pf1);
#pragma unroll
        for (int eb = 0; eb < 4; ++eb) {
#pragma unroll
            for (int s2 = 0; s2 < 2; ++s2) {
                float v[8];
#pragma unroll
                for (int i = 0; i < 8; ++i) { int kl = 16 * s2 + 8 * (i >> 2) + 4 * hi + (i & 3); kl = kl < nvalid ? kl : nvalid - 1; v[i] = vbase[(size_t)kl * 512 + eb * 32 + j]; }
                const bf16x8 vf = __builtin_bit_cast(bf16x8, (u32x4){pk2(v[0], v[1]), pk2(v[2], v[3]), pk2(v[4], v[5]), pk2(v[6], v[7])});
                oT[eb] = MFMA32(vf, s2 == 0 ? pf0 : pf1, oT[eb]);
            }
        }
    }
    l += shx(l, 32);
    LAS float* Mw = (LAS float*)lds; LAS float* Lw = Mw + 64; LAS float* Ow = Mw + 128;
    if (j < 8) {
        if (hi == 0) { Mw[wave * 8 + j] = m; Lw[wave * 8 + j] = l; }
#pragma unroll
        for (int eb = 0; eb < 4; ++eb)
#pragma unroll
            for (int r = 0; r < 16; ++r) Ow[(wave * 8 + j) * 128 + eb * 32 + crow(r, hi)] = oT[eb][r];
    }
    __syncthreads();
    if (wave < 4) {
        const int qq = wave; float d[2];
        float o0[2], o1[2];
#pragma unroll
        for (int cc = 0; cc < 2; ++cc) {
            const int jj = cc * 4 + qq; float M = -1e30f;
#pragma unroll
            for (int w = 0; w < 8; ++w) M = fmaxf(M, Mw[w * 8 + jj]);
            float L = 0.f, a0 = 0.f, a1 = 0.f;
#pragma unroll
            for (int w = 0; w < 8; ++w) { const float f = ex2(Mw[w * 8 + jj] - M); L += Lw[w * 8 + jj] * f; a0 += Ow[(w * 8 + jj) * 128 + lane] * f; a1 += Ow[(w * 8 + jj) * 128 + 64 + lane] * f; }
            const float il = 1.0f / L;
            if (cc == 0) { o0[0] = a0 * il; o0[1] = a1 * il; } else { o1[0] = a0 * il; o1[1] = a1 * il; }
        }
        d[0] = o0[0] - lam * o1[0]; d[1] = o0[1] - lam * o1[1];
        const float ss = wave_sum(d[0] * d[0] + d[1] * d[1]);
        const float rn = (1.0f - LAM_INIT) / sqrtf(ss * (1.f / 128.f) + RMS_EPS);
        const float* gs = P.in[I_GSUB];
        bf16* op = WSP(bf16, WS_A2) + ((size_t)(RP + db * 4 + qq)) * 1024 + h * 128;
        op[lane] = (bf16)(pk2(d[0] * rn * gs[lane], 0.f) & 0xffffu);
        op[64 + lane] = (bf16)(pk2(d[1] * rn * gs[64 + lane], 0.f) & 0xffffu);
    }
    __syncthreads();
}

__device__ __forceinline__ void ssm_scan_unit(KPR P, LAS unsigned char* lds, int b, int g, int tid, int wave, int lane) {
    const int j = lane & 31, hi = lane >> 5;
    bf16* Xg = WSP(bf16, WS_XG);
    const bf16* Mt = WSP(bf16, WS_MT) + (size_t)g * 128 * 256;
    const size_t rowbase = (size_t)g * 1024 + b * 256 + wave * 32;
    f32x16 acc[4];
#pragma unroll
    for (int nb = 0; nb < 4; ++nb)
#pragma unroll
        for (int r = 0; r < 16; ++r) acc[nb][r] = 0.f;
    const bf16* ap = Xg + (rowbase + j) * 384 + 8 * hi;
    const bf16* bp = Mt + (size_t)j * 256 + 8 * hi;
#pragma unroll 4
    for (int s = 0; s < 16; ++s) {
        const bf16x8 af = *(const bf16x8*)(ap + 16 * s);
#pragma unroll
        for (int nb = 0; nb < 4; ++nb) { const bf16x8 bf = *(const bf16x8*)(bp + (size_t)nb * 32 * 256 + 16 * s); acc[nb] = MFMA32(af, bf, acc[nb]); }
    }
    LAS float* Sl = (LAS float*)lds + wave * 4096;
#pragma unroll
    for (int nb = 0; nb < 4; ++nb)
#pragma unroll
        for (int r = 0; r < 16; ++r) Sl[crow(r, hi) * 128 + nb * 32 + j] = acc[nb][r];
    const float* SC = WSP(float, WS_SC);
    const int p = lane;
    const float ar = SC[SC_LB16 + (g * 64 + p) * 2], ai = SC[SC_LB16 + (g * 64 + p) * 2 + 1];
    const float br = SC[SC_LB512 + (g * 64 + p) * 2], bi = SC[SC_LB512 + (g * 64 + p) * 2 + 1];
    float sr = 0.f, si = 0.f;
    for (int c = 0; c < 32; ++c) { const float ur = Sl[c * 128 + p], ui = Sl[c * 128 + 64 + p]; const float nr = ar * sr - ai * si + ur, ni = ar * si + ai * sr + ui; sr = nr; si = ni; }
    LAS float* E = (LAS float*)(lds + RING_BYTES);
    E[wave * 128 + p] = sr; E[wave * 128 + 64 + p] = si;
    __syncthreads();
    float cr = 0.f, ci = 0.f;
    for (int w = 0; w < wave; ++w) { const float er = E[w * 128 + p], ei = E[w * 128 + 64 + p]; const float nr = br * cr - bi * ci + er, ni = br * ci + bi * cr + ei; cr = nr; ci = ni; }
    sr = cr; si = ci;
    for (int c = 0; c < 32; ++c) {
        bf16* xp = Xg + (rowbase + c) * 384 + 256;
        xp[p] = (bf16)(pk2(sr, 0.f) & 0xffffu); xp[64 + p] = (bf16)(pk2(si, 0.f) & 0xffffu);
        const float ur = Sl[c * 128 + p], ui = Sl[c * 128 + 64 + p]; const float nr = ar * sr - ai * si + ur, ni = ar * si + ai * sr + ui; sr = nr; si = ni; }
    if (wave == 7) { P.out[O_SRP + (size_t)(b * 32 + g) * 64 + p] = sr; P.out[O_SIP + (size_t)(b * 32 + g) * 64 + p] = si; }
    __syncthreads();
}

__device__ __forceinline__ void ssm_sample_task(KPR P, LAS float* scr, int db, int g, int lane) {
    const float* SC = WSP(float, WS_SC);
    const int p = lane;
    const float ar = SC[SC_LB1 + (g * 64 + p) * 2], ai = SC[SC_LB1 + (g * 64 + p) * 2 + 1];
    float sr = P.in[I_SRE][(size_t)(db * 32 + g) * 64 + p], si = P.in[I_SIM][(size_t)(db * 32 + g) * 64 + p];
    const float* bb = SC + SC_BB + (size_t)(g * 64 + p) * 32;
    const float* Us = WSP(float, WS_US) + (size_t)(db * 4) * 512 + g * 16;
    for (int t = 0; t < 4; ++t) {
        float ur = 0.f, ui = 0.f;
#pragma unroll
        for (int ch = 0; ch < 16; ++ch) { const float u = Us[t * 512 + ch]; ur += bb[2 * ch] * u; ui += bb[2 * ch + 1] * u; }
        const float nr = ar * sr - ai * si + ur, ni = ar * si + ai * sr + ui; sr = nr; si = ni;
        scr[t * 128 + p] = sr; scr[t * 128 + 64 + p] = si;
    }
    P.out[O_SRS + (size_t)(db * 32 + g) * 64 + p] = sr; P.out[O_SIS + (size_t)(db * 32 + g) * 64 + p] = si;
    asm volatile("s_waitcnt lgkmcnt(0)" ::: "memory");
    const int t = lane >> 4, hh = lane & 15;
    const float* cre = P.in[I_CRE] + (size_t)(g * 16 + hh) * 64; const float* cim = P.in[I_CIM] + (size_t)(g * 16 + hh) * 64;
    float y = P.in[I_D][g * 16 + hh] * Us[t * 512 + hh];
    for (int pp = 0; pp < 64; ++pp) y += cre[pp] * scr[t * 128 + pp] - cim[pp] * scr[t * 128 + 64 + pp];
    WSP(bf16, WS_G)[(size_t)(RP + db * 4 + t) * 512 + g * 16 + hh] = (bf16)(pk2(gelu_tanh(y), 0.f) & 0xffffu);
    asm volatile("s_waitcnt lgkmcnt(0)" ::: "memory");
}

__device__ __forceinline__ void memattn_sample_unit(KPR P, LAS unsigned char* lds, int db, int h, int tid, int wave, int lane) {
    LAS float* S = (LAS float*)lds;
    LAS float* Op = S + 1024;
    const float* Qs = WSP(float, WS_QS) + (size_t)(db * 4) * 1024 + h * 256;
    f32x4 qv[4];
#pragma unroll
    for (int qq = 0; qq < 4; ++qq) qv[qq] = *(const f32x4*)(Qs + (size_t)qq * 1024 + 4 * lane);
    const float* Kc = P.in[I_CMK] + ((size_t)db * 256 * 4 + h) * 256;
    const float* Vc = P.in[I_CMV] + ((size_t)db * 256 * 4 + h) * 256;
    for (int kk = 0; kk < 32; kk += 4) {
        f32x4 kv[4];
#pragma unroll
        for (int u = 0; u < 4; ++u) kv[u] = *(const f32x4*)(Kc + (size_t)(wave * 32 + kk + u) * 1024 + 4 * lane);
#pragma unroll
        for (int u = 0; u < 4; ++u) {
#pragma unroll
            for (int qq = 0; qq < 4; ++qq) {
                float d = (kv[u][0] * qv[qq][0] + kv[u][1] * qv[qq][1]) + (kv[u][2] * qv[qq][2] + kv[u][3] * qv[qq][3]);
                d = wave_sum(d);
                if (lane == 0) S[qq * 256 + wave * 32 + kk + u] = d;
            }
        }
    }
    __syncthreads();
    if (wave < 4) {
        float v[4]; float mx = -1e30f;
#pragma unroll
        for (int i = 0; i < 4; ++i) { v[i] = S[wave * 256 + lane + 64 * i]; mx = fmaxf(mx, v[i]); }
#pragma unroll
        for (int o = 1; o < 64; o <<= 1) mx = fmaxf(mx, shx(mx, o));
        float sm = 0.f;
#pragma unroll
        for (int i = 0; i < 4; ++i) { v[i] = ex2(v[i] - mx); sm += v[i]; }
        sm = wave_sum(sm); const float il = 1.0f / sm;
#pragma unroll
        for (int i = 0; i < 4; ++i) S[wave * 256 + lane + 64 * i] = v[i] * il;
    }
    __syncthreads();
    f32x4 o[4];
#pragma unroll
    for (int qq = 0; qq < 4; ++qq) o[qq] = (f32x4){0.f, 0.f, 0.f, 0.f};
    for (int kk = 0; kk < 32; kk += 4) {
        f32x4 vv[4];
#pragma unroll
        for (int u = 0; u < 4; ++u) vv[u] = *(const f32x4*)(Vc + (size_t)(wave * 32 + kk + u) * 1024 + 4 * lane);
#pragma unroll
        for (int u = 0; u < 4; ++u)
#pragma unroll
            for (int qq = 0; qq < 4; ++qq) o[qq] += vv[u] * S[qq * 256 + wave * 32 + kk + u];
    }
#pragma unroll
    for (int qq = 0; qq < 4; ++qq) *(LAS f32x4*)(Op + (wave * 4 + qq) * 256 + 4 * lane) = o[qq];
    __syncthreads();
    {
        const int qq = tid >> 7, e0 = (tid & 127) * 2;
        float a0 = 0.f, a1 = 0.f;
#pragma unroll
        for (int w = 0; w < 8; ++w) { a0 += Op[(w * 4 + qq) * 256 + e0]; a1 += Op[(w * 4 + qq) * 256 + e0 + 1]; }
        *(unsigned*)(WSP(bf16, WS_OM) + (size_t)(RP + db * 4 + qq) * 1024 + h * 256 + e0) = pk2(a0, a1);
    }
    __syncthreads();
}

template <bool NEXT>
__device__ __forceinline__ void norm_pass(KPR P, const float* T, const float* ss, const float* baseP, const float* baseS, const float* gpost, float* YoutP, float* YoutS,
                                          const float* gpre, bf16* A, int gw, int NGW, int lane) {
    for (int row = gw; row < RT; row += NGW) {
        const f32x4* tr = (const f32x4*)(T + (size_t)row * 1024) + lane;
        const f32x4* br = (const f32x4*)((row < RP) ? baseP + (size_t)row * 1024 : baseS + (size_t)(row - RP) * 1024) + lane;
        f32x4* yo = (f32x4*)((row < RP) ? YoutP + (size_t)row * 1024 : YoutS + (size_t)(row - RP) * 1024) + lane;
        const float r1 = 1.0f / sqrtf(ss[row] * (1.f / 1024.f) + RMS_EPS);
        f32x4 y[4]; float s = 0.f;
#pragma unroll
        for (int jj = 0; jj < 4; ++jj) { const f32x4 g = ((const f32x4*)gpost)[lane + 64 * jj]; y[jj] = br[64 * jj] + tr[64 * jj] * r1 * g; yo[64 * jj] = y[jj];
            s += (y[jj].x * y[jj].x + y[jj].y * y[jj].y) + (y[jj].z * y[jj].z + y[jj].w * y[jj].w); }
        if (NEXT) {
            const float r2 = 1.0f / sqrtf(wave_sum(s) * (1.f / 1024.f) + RMS_EPS);
            unsigned long long* o8 = (unsigned long long*)(A + (size_t)row * 1024) + lane;
#pragma unroll
            for (int jj = 0; jj < 4; ++jj) { const f32x4 g = ((const f32x4*)gpre)[lane + 64 * jj];
                o8[64 * jj] = (unsigned long long)pk2(y[jj].x * r2 * g.x, y[jj].y * r2 * g.y) | ((unsigned long long)pk2(y[jj].z * r2 * g.z, y[jj].w * r2 * g.w) << 32); }
        }
    }
}

#ifndef PHMASK
#define PHMASK 0xFFFFF
#endif
#define PH(k) if constexpr (((PHMASK) >> (k)) & 1)
__global__ void __launch_bounds__(NWAVES * 64, 2) fwd_kernel(KP P_unused) {
    (void)P_unused;
    extern __shared__ __attribute__((aligned(16))) unsigned char lds_raw[];
    LAS unsigned char* lds = (LAS unsigned char*)lds_raw;
    volatile LAS unsigned* MISC = (volatile LAS unsigned*)(lds + RING_BYTES + 8192);
#define IDS() KPR P = *kp_get(); int tid = threadIdx.x; asm volatile("" : "+v"(tid)); const int lane = tid & 63, wave = __builtin_amdgcn_readfirstlane(tid >> 6); const int gw = vcu * NWAVES + wave; (void)lane; (void)gw
    const int G = gridDim.x, bx = blockIdx.x;
    const int vcu = (G % 8 == 0) ? (bx % 8) * (G / 8) + bx / 8 : bx;
    const int NGW = G * NWAVES;
    if (threadIdx.x < 32) MISC[threadIdx.x] = 0u;
    __syncthreads();
    XcdBarrier bar;
    { KPR P = *kp_get(); bar = xcd_barrier_post(WSP(unsigned, WS_CTL) + CW_BAR, MISC + 8); }
#define CTLF (WSP(float, WS_CTL))

    PH(0) { IDS(); p0_prologue(P, lds, vcu, G, tid, wave, lane); }
    xcd_barrier(bar);

    PH(1) {
        KPR P = *kp_get();
        pg8::Gemm g{WSP(bf16, WS_XN), WSP(bf16, WS_WIN), RALL, 4096, 1024};
        OrdInProj S{G, bx};
        EpiInProj E{P.out, WSP(bf16, WS_QB), WSP(bf16, WS_KB), WSP(bf16, WS_VB), WSP(bf16, WS_XG), WSP(bf16, WS_MKH), WSP(bf16, WS_MVH), WSP(float, WS_US)};
        pg8::gemm_phase<EpiInProj, OrdInProj, true, true>(lds, g, S, E);
    }
    xcd_barrier(bar);

    {
        for (int pass = 0; pass < 2; ++pass) {
            if ((pass ^ (vcu & 1)) == 0) {
                PH(16) { IDS(); const float lam = WSP(float, WS_SC)[SC_MISC];
                    for (int it = vcu; it < 512; it += G) attn_sample_unit(P, lds, it >> 2, it & 3, lam, tid, wave, lane); }
            } else {
                PH(17) { IDS(); const float lam = WSP(float, WS_SC)[SC_MISC];
                    for (int it = vcu; it < 256; it += G) { const int bh = it >> 4, pr = it & 15;
                        attn_prompt_unit(P, lds, bh >> 2, bh & 3, pr, lam, tid, wave, lane);
                        attn_prompt_unit(P, lds, bh >> 2, bh & 3, 31 - pr, lam, tid, wave, lane); } }
            }
        }
        PH(18) { IDS(); for (int it = vcu; it < 128; it += G) ssm_scan_unit(P, lds, it >> 5, it & 31, tid, wave, lane); }
        {
            IDS();
            const bf16* MVh = WSP(bf16, WS_MVH); bf16* MVt = WSP(bf16, WS_MVT);
            for (int idx = gw * 64 + lane; idx < 16 * 256 * 256; idx += NGW * 64) { const int bh = idx >> 16, e = (idx >> 8) & 255, key = idx & 255; MVt[idx] = MVh[((size_t)bh * 256 + key) * 256 + e]; }
        }
        PH(19) { IDS(); for (int task = gw; task < 4096; task += NGW) ssm_sample_task(P, (LAS float*)(lds + wave * 2048), task >> 5, task & 31, lane); }
    }
    xcd_barrier(bar);

    PH(3) {
        KPR P = *kp_get();
        int K3 = 384; asm volatile("" : "+s"(K3));
        pg8::Gemm g{WSP(bf16, WS_XG), WSP(bf16, WS_TF), 32768, 8192, K3};
        OrdDiag S{128, 2, G, vcu};
        EpiS3 E{WSP(bf16, WS_G)};
        pg8::gemm_phase<EpiS3, OrdDiag, true, true>(lds, g, S, E);
    }
    xcd_barrier(bar);

    PH(4) {
        KPR P = *kp_get();
        pg8::Gemm g{WSP(bf16, WS_G), WSP(bf16, WS_WGLU), RT, 512, 512};
        OrdStatic S{66, 2, G, bx};
        EpiGlu E{WSP(bf16, WS_G), WSP(float, WS_Z), CTLF + CW_SSGLU};
        pg8::gemm_phase<EpiGlu, OrdStatic, true, true>(lds, g, S, E);
    }
    xcd_barrier(bar);

    PH(5) {
        IDS();
        const float* Z = WSP(float, WS_Z); const float* ss = CTLF + CW_SSGLU; bf16* A2 = WSP(bf16, WS_A2); const float* gg = P.in[I_GSSM];
        for (int row = gw; row < RT; row += NGW) {
            const float r = 1.0f / sqrtf(ss[row] * (1.f / 512.f) + RMS_EPS);
            const f32x4 z0 = *(const f32x4*)(Z + (size_t)row * 512 + 8 * lane), z1 = *(const f32x4*)(Z + (size_t)row * 512 + 8 * lane + 4);
            const f32x4 g0 = *(const f32x4*)(gg + 8 * lane), g1 = *(const f32x4*)(gg + 8 * lane + 4);
            *(u32x4*)(A2 + (size_t)row * 1024 + 512 + 8 * lane) = pk8(z0 * r * g0, z1 * r * g1);
        }
    }
    xcd_barrier(bar);

    PH(6) {
        KPR P = *kp_get();
        pg8::Gemm g{WSP(bf16, WS_A2), WSP(bf16, WS_WOUT), RT, 1024, 1024};
        OrdStatic S{66, 4, G, bx};
        EpiF32SS E{WSP(float, WS_T), CTLF + CW_SS1};
        pg8::gemm_phase<EpiF32SS, OrdStatic, true, true>(lds, g, S, E);
    }
    xcd_barrier(bar);

    PH(7) { IDS(); norm_pass<true>(P, WSP(float, WS_T), CTLF + CW_SS1, P.in[I_XP], P.in[I_XS], P.in[I_GMIXPOST], WSP(float, WS_Y1), WSP(float, WS_Y1) + (size_t)RP * 1024,
                    P.in[I_GMEMPRE], WSP(bf16, WS_A3), gw, NGW, lane); }
    xcd_barrier(bar);

    PH(8) {
        KPR P = *kp_get();
        pg8::Gemm g{WSP(bf16, WS_A3), WSP(bf16, WS_WMQ), RT, 1024, 1024};
        OrdStatic S{66, 4, G, bx};
        EpiMq E{WSP(bf16, WS_QH), WSP(float, WS_QS)};
        pg8::gemm_phase<EpiMq, OrdStatic, true, true>(lds, g, S, E);
    }
    xcd_barrier(bar);

    PH(9) {
        KPR P = *kp_get();
        int K9 = 256; asm volatile("" : "+s"(K9));
        pg8::Gemm g{WSP(bf16, WS_QH), WSP(bf16, WS_MKH), 65536, 4096, K9};
        OrdDiag S{256, 4, G, vcu};
        EpiMemQK E{WSP(bf16, WS_PM), CTLF + CW_RSUM};
        pg8::gemm_phase<EpiMemQK, OrdDiag, true, true>(lds, g, S, E);
        __syncthreads();
        PH(2) { IDS(); for (int it = vcu; it < 512; it += G) memattn_sample_unit(P, lds, it >> 2, it & 3, tid, wave, lane); }
    }
    xcd_barrier(bar);

    PH(10) {
        KPR P = *kp_get();
        int K10 = 256; asm volatile("" : "+s"(K10));
        pg8::Gemm g{WSP(bf16, WS_PM), WSP(bf16, WS_MVT), 65536, 4096, K10};
        OrdDiag S{256, 4, G, vcu};
        EpiMemPV E{WSP(bf16, WS_OM), CTLF + CW_RSUM};
        pg8::gemm_phase<EpiMemPV, OrdDiag, true, true>(lds, g, S, E);
    }
    xcd_barrier(bar);

    PH(11) {
        KPR P = *kp_get();
        pg8::Gemm g{WSP(bf16, WS_OM), WSP(bf16, WS_WMO), RT, 1024, 1024};
        OrdStatic S{66, 4, G, bx};
        EpiF32SS E{WSP(float, WS_T), CTLF + CW_SS2};
        pg8::gemm_phase<EpiF32SS, OrdStatic, true, true>(lds, g, S, E);
    }
    xcd_barrier(bar);

    PH(12) { IDS(); norm_pass<true>(P, WSP(float, WS_T), CTLF + CW_SS2, WSP(float, WS_Y1), WSP(float, WS_Y1) + (size_t)RP * 1024, P.in[I_GMEMPOST], WSP(float, WS_Y2), WSP(float, WS_Y2) + (size_t)RP * 1024,
                    P.in[I_GFFNPRE], WSP(bf16, WS_A4), gw, NGW, lane); }
    xcd_barrier(bar);

    PH(13) {
        KPR P = *kp_get();
        pg8::Gemm g{WSP(bf16, WS_A4), WSP(bf16, WS_WGU), RT, 5632, 1024};
        OrdStatic S{66, 22, G, bx};
        EpiSwiglu E{WSP(bf16, WS_H)};
        pg8::gemm_phase<EpiSwiglu, OrdStatic, true, true>(lds, g, S, E);
    }
    xcd_barrier(bar);

    PH(14) {
        KPR P = *kp_get();
        pg8::Gemm g{WSP(bf16, WS_H), WSP(bf16, WS_WD), RT, 1024, 2816};
        OrdStatic S{66, 4, G, bx};
        EpiF32SS E{WSP(float, WS_T), CTLF + CW_SS3};
        pg8::gemm_phase<EpiF32SS, OrdStatic, true, true>(lds, g, S, E);
    }
    xcd_barrier(bar);

    PH(15) { IDS(); norm_pass<false>(P, WSP(float, WS_T), CTLF + CW_SS3, WSP(float, WS_Y2), WSP(float, WS_Y2) + (size_t)RP * 1024, P.in[I_GFFNPOST], P.out + O_YP, P.out + O_YS,
                     nullptr, nullptr, gw, NGW, lane); }
}

extern "C" void kernel_launch(void* const* d_in, const int* in_sizes, int n_in, void* d_out, int out_size, void* d_ws, size_t ws_size, hipStream_t stream) {
    static int grid = 0;
    if (grid == 0) {
        if (n_in != N_IN || out_size != (int)O_END || ws_size < WS_END) { fprintf(stderr, "kernel_launch: unexpected shapes: n_in %d out %d ws %zu (need %zu)\n", n_in, out_size, ws_size, (size_t)WS_END); grid = -1; return; }
        int dev = 0, cus = 0, per_cu = 0;
        if (hipGetDevice(&dev) != hipSuccess || hipDeviceGetAttribute(&cus, hipDeviceAttributeMultiprocessorCount, dev) != hipSuccess) { grid = -1; return; }
        if (hipFuncSetAttribute((const void*)fwd_kernel, hipFuncAttributeMaxDynamicSharedMemorySize, LDS_BYTES) != hipSuccess) { fprintf(stderr, "kernel_launch: hipFuncSetAttribute failed\n"); grid = -1; return; }
        if (hipOccupancyMaxActiveBlocksPerMultiprocessor(&per_cu, (const void*)fwd_kernel, NWAVES * 64, LDS_BYTES) != hipSuccess || per_cu < 1)
            fprintf(stderr, "kernel_launch: occupancy query reports %d workgroups per CU\n", per_cu);
        (void)hipGetLastError();
        grid = cus;
    }
    if (grid < 0) return;
    if (hipMemsetAsync((char*)d_ws + WS_CTL, 0, CTL_ZERO_BYTES, stream) != hipSuccess) { fprintf(stderr, "kernel_launch: memset failed\n"); return; }
    KP a{};
    for (int i = 0; i < N_IN; ++i) a.in[i] = (const float*)d_in[i];
    a.out = (float*)d_out; a.ws = (unsigned char*)d_ws;
    hipLaunchKernelGGL(fwd_kernel, dim3(grid), dim3(NWAVES * 64), LDS_BYTES, stream, a);
    const hipError_t le = hipPeekAtLastError();
    if (le != hipSuccess) fprintf(stderr, "kernel_launch: launch failed: %s\n", hipGetErrorName(le));
}
```
